# Optimizing an MI355X kernel written in HIP

```python
import jax
import jax.numpy as jnp
from jax import lax
import numpy as np

D_MODEL = 1024
BATCH = 8
SEQ = 4096
DEPTH = 1

HEAD_DIM = 64
N_FOX_HEADS = 8
N_SB_HEADS = 8
FOX_WIDTH = N_FOX_HEADS * HEAD_DIM
SB_WIDTH = N_SB_HEADS * HEAD_DIM
N_GROUPS = 4
EXPERTS_PER_GROUP = 4
N_EXPERTS = N_GROUPS * EXPERTS_PER_GROUP
TOP_K_EXPERTS = 2
D_FF_EXPERT = D_MODEL // 2
Q_BLOCK = 128
RMS_EPS = 1e-6
N_MOD = 6
IN_SPLITS = (
    FOX_WIDTH, 2 * FOX_WIDTH, 3 * FOX_WIDTH,
    3 * FOX_WIDTH + N_FOX_HEADS,
    3 * FOX_WIDTH + N_FOX_HEADS + SB_WIDTH,
    3 * FOX_WIDTH + N_FOX_HEADS + 2 * SB_WIDTH,
    3 * FOX_WIDTH + N_FOX_HEADS + 3 * SB_WIDTH,
    3 * FOX_WIDTH + N_FOX_HEADS + 3 * SB_WIDTH + D_MODEL,
)
N_IN = 3 * FOX_WIDTH + N_FOX_HEADS + 3 * SB_WIDTH + 2 * D_MODEL

kernel_name = "hybrid_fox_stickbreak_hmoe"


def rmsnorm(x, g):
    xf = x.astype(jnp.float32)
    xf = xf * lax.rsqrt(jnp.mean(xf * xf, axis=-1, keepdims=True) + RMS_EPS)
    return xf.astype(x.dtype) * g


def to_heads(t, n_heads):
    b, s, _ = t.shape
    return t.reshape(b, s, n_heads, HEAD_DIM).transpose(0, 2, 1, 3)


def from_heads(t):
    b, h, s, d = t.shape
    return t.transpose(0, 2, 1, 3).reshape(b, s, h * d)


def sweep_query_blocks(block_fn, seq):
    n_blocks = seq // Q_BLOCK
    out = lax.map(block_fn, jnp.arange(n_blocks))
    nb, b, h, qb, d = out.shape
    return out.transpose(1, 2, 0, 3, 4).reshape(b, h, nb * qb, d)


def forgetting_attention(q, k, v, log_f):
    seq = q.shape[2]
    scale = HEAD_DIM ** -0.5
    F = jnp.cumsum(log_f, axis=-1)
    kpos = jnp.arange(seq)

    def block(i):
        start = i * Q_BLOCK
        qs = lax.dynamic_slice_in_dim(q, start, Q_BLOCK, axis=2)
        Fq = lax.dynamic_slice_in_dim(F, start, Q_BLOCK, axis=2)
        logits = jnp.einsum("bhqd,bhkd->bhqk", qs, k).astype(jnp.float32) * scale
        logits = logits + Fq[..., :, None] - F[..., None, :]
        qpos = start + jnp.arange(Q_BLOCK)
        mask = kpos[None, :] <= qpos[:, None]
        logits = jnp.where(mask, logits, -jnp.inf)
        p = jax.nn.softmax(logits, axis=-1)
        return jnp.einsum("bhqk,bhkd->bhqd", p.astype(v.dtype), v)

    return sweep_query_blocks(block, seq)


def stick_breaking_attention(q, k, v):
    seq = q.shape[2]
    scale = HEAD_DIM ** -0.5
    kpos = jnp.arange(seq)

    def block(i):
        start = i * Q_BLOCK
        qs = lax.dynamic_slice_in_dim(q, start, Q_BLOCK, axis=2)
        z = jnp.einsum("bhqd,bhkd->bhqk", qs, k).astype(jnp.float32) * scale
        qpos = start + jnp.arange(Q_BLOCK)
        mask = kpos[None, :] < qpos[:, None]
        log_beta = jax.nn.log_sigmoid(z)
        log_one_minus = jnp.where(mask, jax.nn.log_sigmoid(-z), 0.0)
        suffix = lax.cumsum(log_one_minus, axis=3, reverse=True) - log_one_minus
        A = jnp.where(mask, jnp.exp(log_beta + suffix), 0.0)
        return jnp.einsum("bhqk,bhkd->bhqd", A.astype(v.dtype), v)

    return sweep_query_blocks(block, seq)


def hierarchical_moe(h, rg_w, rg_b, re_w, re_b, w_gate, w_up, w_down):
    b, s, d = h.shape
    hf = h.reshape(b * s, d)
    g_prob = jax.nn.softmax((hf @ rg_w + rg_b).astype(jnp.float32), axis=-1)
    g_top_p, g_idx = lax.top_k(g_prob, 1)
    e_logits = (hf @ re_w + re_b).astype(jnp.float32).reshape(b * s, N_GROUPS, EXPERTS_PER_GROUP)
    e_sel = jnp.take_along_axis(e_logits, g_idx[:, :, None], axis=1)[:, 0, :]
    e_prob = jax.nn.softmax(e_sel, axis=-1)
    e_top_p, e_idx = lax.top_k(e_prob, TOP_K_EXPERTS)
    e_top_p = e_top_p / jnp.sum(e_top_p, axis=-1, keepdims=True)
    within = jnp.sum(jax.nn.one_hot(e_idx, EXPERTS_PER_GROUP, dtype=jnp.float32)
                     * e_top_p[..., None], axis=1)
    combine = (jax.nn.one_hot(g_idx[:, 0], N_GROUPS, dtype=jnp.float32)[:, :, None]
               * within[:, None, :] * g_top_p[:, :, None])
    combine = combine.reshape(b * s, N_EXPERTS).astype(h.dtype)
    out = jnp.zeros_like(hf)
    for e in range(N_EXPERTS):
        act = jax.nn.silu(hf @ w_gate[e]) * (hf @ w_up[e])
        out = out + combine[:, e:e + 1] * (act @ w_down[e])
    return out.reshape(b, s, d)


def setup_inputs(seed: int = 0) -> dict:
    key = jax.random.key(seed)
    ks = jax.random.split(key, 20)
    D, L = D_MODEL, DEPTH

    def nrm(k, shape, scale):
        return jax.random.normal(k, shape, jnp.float32) * scale

    return {
        "x": nrm(ks[0], (BATCH, SEQ, D), 1.0),
        "c": nrm(ks[1], (BATCH, D), 1.0),
        "ada_w": nrm(ks[2], (L, D, N_MOD * D), 0.5 * D ** -0.5),
        "ada_b": nrm(ks[3], (L, N_MOD * D), 0.02),
        "norm1_g": 1.0 + nrm(ks[4], (L, D), 0.02),
        "w_in": nrm(ks[5], (L, D, N_IN), D ** -0.5),
        "b_forget": 2.0 + nrm(ks[6], (L, N_FOX_HEADS), 0.1),
        "w_branch_fox": nrm(ks[7], (L, FOX_WIDTH, D), FOX_WIDTH ** -0.5),
        "w_branch_sb": nrm(ks[8], (L, SB_WIDTH, D), SB_WIDTH ** -0.5),
        "w_out": nrm(ks[9], (L, D, D), D ** -0.5),
        "norm2_g": 1.0 + nrm(ks[10], (L, D), 0.02),
        "router_group_w": nrm(ks[11], (L, D, N_GROUPS), D ** -0.5),
        "router_group_b": nrm(ks[12], (L, N_GROUPS), 0.01),
        "router_expert_w": nrm(ks[13], (L, D, N_EXPERTS), D ** -0.5),
        "router_expert_b": nrm(ks[14], (L, N_EXPERTS), 0.01),
        "expert_w_gate": nrm(ks[15], (L, N_EXPERTS, D, D_FF_EXPERT), D ** -0.5),
        "expert_w_up": nrm(ks[16], (L, N_EXPERTS, D, D_FF_EXPERT), D ** -0.5),
        "expert_w_down": nrm(ks[17], (L, N_EXPERTS, D_FF_EXPERT, D), D_FF_EXPERT ** -0.5),
        "final_g": 1.0 + nrm(ks[18], (D,), 0.02),
    }


def reference(x, c, ada_w, ada_b, norm1_g, w_in, b_forget, w_branch_fox, w_branch_sb, w_out,
              norm2_g, router_group_w, router_group_b, router_expert_w, router_expert_b,
              expert_w_gate, expert_w_up, expert_w_down, final_g):
    c_act = jax.nn.silu(c)
    for l in range(DEPTH):
        mod = c_act @ ada_w[l] + ada_b[l]
        shift1, scale1, gate1, shift2, scale2, gate2 = [m[:, None, :] for m in jnp.split(mod, N_MOD, axis=-1)]

        h = rmsnorm(x, norm1_g[l]) * (1.0 + scale1) + shift1
        proj = h @ w_in[l]
        qa, ka, va, fa, qb, kb, vb, ga, gb = jnp.split(proj, IN_SPLITS, axis=-1)
        log_f = jax.nn.log_sigmoid((fa + b_forget[l]).astype(jnp.float32)).transpose(0, 2, 1)
        o_fox = forgetting_attention(to_heads(qa, N_FOX_HEADS), to_heads(ka, N_FOX_HEADS),
                                     to_heads(va, N_FOX_HEADS), log_f)
        o_sb = stick_breaking_attention(to_heads(qb, N_SB_HEADS), to_heads(kb, N_SB_HEADS),
                                        to_heads(vb, N_SB_HEADS))
        merged = (jax.nn.sigmoid(ga) * (from_heads(o_fox) @ w_branch_fox[l])
                  + jax.nn.sigmoid(gb) * (from_heads(o_sb) @ w_branch_sb[l]))
        x = x + gate1 * (merged @ w_out[l])

        h2 = rmsnorm(x, norm2_g[l]) * (1.0 + scale2) + shift2
        y = hierarchical_moe(h2, router_group_w[l], router_group_b[l], router_expert_w[l],
                             router_expert_b[l], expert_w_gate[l], expert_w_up[l], expert_w_down[l])
        x = x + gate2 * y
    return rmsnorm(x, final_g)
```

```cpp
#include <hip/hip_runtime.h>
#include <cstdio>
#include <cstdint>

#define GAS __attribute__((address_space(1)))
#define LAS __attribute__((address_space(3)))
typedef unsigned short bf16;
typedef unsigned v4u __attribute__((ext_vector_type(4)));
typedef unsigned v2u __attribute__((ext_vector_type(2)));
typedef float f32x4 __attribute__((ext_vector_type(4)));
typedef float f32x2 __attribute__((ext_vector_type(2)));
typedef short bf16x8 __attribute__((ext_vector_type(8)));

constexpr int BATCH = 8, SEQ = 4096, D = 1024, NTOK = BATCH * SEQ, HD = 64;
constexpr int NIN = 5128, NP1 = 5120, NE = 16, DFF = 512, NMOD = 6;
constexpr float RMS_EPS = 1e-6f;
constexpr float LOG2E = 1.4426950408889634f;
constexpr float C2 = 0.125f * 1.4426950408889634f;
constexpr int NWAVES = 8;

constexpr size_t MiB = 1u << 20;
constexpr size_t WS_CTL = 0, CTL_ZERO_BYTES = 1 * MiB;
constexpr size_t WS_MOD = 1 * MiB;
constexpr size_t WS_LOGF = 1 * MiB + 256 * 1024;
constexpr size_t WS_F = 2 * MiB + 256 * 1024;
constexpr size_t WS_LIST = 4 * MiB;
constexpr size_t WS_LW = 6 * MiB;
constexpr size_t WS_WIN = 8 * MiB;
constexpr size_t WS_WBR = 18 * MiB;
constexpr size_t WS_WOUT = 20 * MiB;
constexpr size_t WS_WGU = 22 * MiB;
constexpr size_t WS_WD = 54 * MiB;
constexpr size_t WS_XN = 72 * MiB;
constexpr size_t WS_Q = 136 * MiB;
constexpr size_t WS_K = 200 * MiB;
constexpr size_t WS_V = 264 * MiB;
constexpr size_t WS_GA = 328 * MiB;
constexpr size_t WS_GB = 392 * MiB;
constexpr size_t WS_ACT = 136 * MiB;
constexpr size_t WS_Y = 328 * MiB;
constexpr size_t WS_END = 456 * MiB;
constexpr int CW_BAR = 4096;
constexpr int CW_CNT = 16384;

constexpr int RING_BYTES = 131072;
constexpr int MISC_OFF = RING_BYTES;
constexpr int TAB_OFF = RING_BYTES + 1024;
constexpr int LDS_BYTES = 147456;

__device__ __forceinline__ unsigned f2bf(float f) { unsigned u = __builtin_bit_cast(unsigned, f); return (u + 0x7fffu + ((u >> 16) & 1u)) >> 16; }
__device__ __forceinline__ unsigned pk2(float lo, float hi) { return f2bf(lo) | (f2bf(hi) << 16); }
__device__ __forceinline__ float bflo(unsigned w) { return __builtin_bit_cast(float, w << 16); }
__device__ __forceinline__ float bfhi(unsigned w) { return __builtin_bit_cast(float, w & 0xffff0000u); }
#define LDS_WAIT() asm volatile("s_waitcnt lgkmcnt(0)" ::: "memory")
#define VM_WAIT() asm volatile("s_waitcnt vmcnt(0)" ::: "memory")

namespace pg8 {
#define PG8_LAS __attribute__((address_space(3)))
typedef unsigned short bf16_t;
typedef unsigned u32x4 __attribute__((ext_vector_type(4)));
constexpr int BM = 256, BK = 64, HALF = 128, HTB = HALF * BK * 2, STAGE_BYTES = 8 * HTB, NXCD = 8, WGM = 8;

__host__ __device__ __forceinline__ int lds_byte(int r, int c) { const int st = (r >> 4) * 2 + (c >> 5), rr = r & 15, cc = c & 31, ob = rr * 64 + cc * 2; return st * 1024 + (ob ^ (((ob >> 9) & 1) << 5)); }
__host__ __device__ __forceinline__ void stage_rc(int b, int& R, int& C) { const int st = b / 1024, sb = b % 1024, swz = sb ^ (((sb >> 9) & 1) << 5); R = (st >> 1) * 16 + swz / 64; C = (st & 1) * 32 + (swz % 64) / 2; }
__host__ __device__ __forceinline__ int perm32(int rho) { const int n = rho >> 4, i = rho & 15; return 8 * (i >> 2) + 4 * n + (i & 3); }

struct Unit { int pm, pn, e, row0; };
struct Gemm { const bf16_t* A; const bf16_t* Bt; int K, lda, ldb; };

struct StaticOrder {
    int nM, nN, nwg, G, c;
    __device__ void init(int M, int N, int G_, int c_) { nM = M / BM; nN = N / BM; nwg = nM * nN; G = G_; c = c_; }
    __device__ __forceinline__ bool next(int i, Unit& u) const {
        const long L = (long)i * G + c; if (L >= nwg) return false;
        int wgid = (int)L; { const int q = nwg / NXCD, r = nwg % NXCD, xcd = wgid % NXCD, off = wgid / NXCD; wgid = (xcd < r ? xcd * (q + 1) : r * (q + 1) + (xcd - r) * q) + off; }
        const int nig = WGM * nN, gid = wgid / nig, fm = gid * WGM, gsz = (nM - fm) < WGM ? (nM - fm) : WGM;
        u.pm = fm + ((wgid % nig) % gsz); u.pn = (wgid % nig) / gsz; u.e = 0; u.row0 = 0; return true;
    }
    __device__ __forceinline__ const char* abase(const Gemm& g, const Unit& u) const { return (const char*)g.A + (size_t)u.pm * BM * g.lda * 2; }
    __device__ __forceinline__ const char* bbase(const Gemm& g, const Unit& u) const { return (const char*)g.Bt + (size_t)u.pn * BM * g.ldb * 2; }
};
struct MoeOrder {
    const PG8_LAS int* tab; int G, c; size_t estride; bool gatherA;
    __device__ __forceinline__ bool next(int i, Unit& u) const {
        const int ln = (int)(threadIdx.x & 63); const int tv = tab[ln & 31];
        const int RT = __builtin_amdgcn_readlane(tv, 16); const int L = i * G + c; if (L >= RT * 4) return false;
        const int rt = L >> 2;
        const int e = __builtin_popcountll(__ballot(ln >= 1 && ln < 16 && rt >= tv));
        const int tpe = __builtin_amdgcn_readfirstlane(tab[e]);
        u.pm = rt; u.pn = L & 3; u.e = e; u.row0 = (rt - tpe) * BM; return true;
    }
    __device__ __forceinline__ const char* abase(const Gemm& g, const Unit& u) const { return gatherA ? (const char*)g.A : (const char*)g.A + (size_t)u.pm * BM * g.lda * 2; }
    __device__ __forceinline__ const char* bbase(const Gemm& g, const Unit& u) const { return (const char*)g.Bt + (size_t)u.e * estride + (size_t)u.pn * BM * g.ldb * 2; }
};

__device__ __forceinline__ unsigned cvt_pk_bf16(float lo, float hi) { unsigned r; asm volatile("v_cvt_pk_bf16_f32 %0, %1, %2" : "=v"(r) : "v"(lo), "v"(hi)); return r; }

struct EpiSplit {
    static constexpr bool PERM = true, HAS_MID = false;
    bf16_t* O; int ldc; int split_cols; size_t split_stride; float scale0;
    __device__ __forceinline__ void operator()(const f32x4 (&acc)[2][2][4][2], const Unit& u, int wr, int wc, int fr, int fq) const {
        const int row0 = u.pm * BM + wr * 64 + fr; int colt = u.pn * BM; bf16_t* base = O;
        float sc = 1.f; { const int t = colt / split_cols; base += (size_t)t * split_stride; colt -= t * split_cols; if (t == 0) sc = scale0; }
        const int col0 = colt + wc * 32 + 8 * fq;
#pragma unroll
        for (int ai = 0; ai < 2; ++ai)
#pragma unroll
            for (int m = 0; m < 4; ++m) { bf16_t* rowp = base + (size_t)(row0 + ai * HALF + m * 16) * ldc + col0;
#pragma unroll
                for (int bj = 0; bj < 2; ++bj) { f32x4 v0 = acc[ai][bj][m][0] * sc, v1 = acc[ai][bj][m][1] * sc;
                    u32x4 w; w.x = cvt_pk_bf16(v0[0], v0[1]); w.y = cvt_pk_bf16(v0[2], v0[3]); w.z = cvt_pk_bf16(v1[0], v1[1]); w.w = cvt_pk_bf16(v1[2], v1[3]);
                    *(u32x4*)(rowp + bj * HALF) = w; } }
    }
    __device__ __forceinline__ void mid(f32x4 (&)[2][2][4][2], const Unit&, int, int, int, int) const {}
};
struct EpiMerge {
    static constexpr bool PERM = true, HAS_MID = true;
    const bf16_t* GA; const bf16_t* GB; bf16_t* O;
    __device__ __forceinline__ void mid(f32x4 (&acc)[2][2][4][2], const Unit& u, int wr, int wc, int fr, int fq) const {
        const int row0 = u.pm * BM + wr * 64 + fr, col0 = u.pn * BM + wc * 32 + 8 * fq;
#pragma unroll
        for (int ai = 0; ai < 2; ++ai)
#pragma unroll
            for (int m = 0; m < 4; ++m) { const size_t ro = (size_t)(row0 + ai * HALF + m * 16) * D + col0;
#pragma unroll
                for (int bj = 0; bj < 2; ++bj) { const u32x4 a = *(const u32x4*)(GA + ro + bj * HALF), b = *(const u32x4*)(GB + ro + bj * HALF);
                    float r[8];
#pragma unroll
                    for (int j = 0; j < 4; ++j) { const float a0 = bflo(a[j]), a1 = bfhi(a[j]), b0 = bflo(b[j]), b1 = bfhi(b[j]);
                        r[2 * j] = (1.f + __expf(-b0)) / (1.f + __expf(-a0)); r[2 * j + 1] = (1.f + __expf(-b1)) / (1.f + __expf(-a1)); }
                    acc[ai][bj][m][0] = acc[ai][bj][m][0] * (f32x4){r[0], r[1], r[2], r[3]}; acc[ai][bj][m][1] = acc[ai][bj][m][1] * (f32x4){r[4], r[5], r[6], r[7]}; } }
    }
    __device__ __forceinline__ void operator()(const f32x4 (&acc)[2][2][4][2], const Unit& u, int wr, int wc, int fr, int fq) const {
        const int row0 = u.pm * BM + wr * 64 + fr, col0 = u.pn * BM + wc * 32 + 8 * fq;
#pragma unroll
        for (int ai = 0; ai < 2; ++ai)
#pragma unroll
            for (int m = 0; m < 4; ++m) { const size_t ro = (size_t)(row0 + ai * HALF + m * 16) * D + col0;
#pragma unroll
                for (int bj = 0; bj < 2; ++bj) { const u32x4 b = *(const u32x4*)(GB + ro + bj * HALF);
                    float s[8];
#pragma unroll
                    for (int j = 0; j < 4; ++j) { s[2 * j] = 1.f / (1.f + __expf(-bflo(b[j]))); s[2 * j + 1] = 1.f / (1.f + __expf(-bfhi(b[j]))); }
                    const f32x4 v0 = acc[ai][bj][m][0] * (f32x4){s[0], s[1], s[2], s[3]}, v1 = acc[ai][bj][m][1] * (f32x4){s[4], s[5], s[6], s[7]};
                    u32x4 w; w.x = cvt_pk_bf16(v0[0], v0[1]); w.y = cvt_pk_bf16(v0[2], v0[3]); w.z = cvt_pk_bf16(v1[0], v1[1]); w.w = cvt_pk_bf16(v1[2], v1[3]);
                    *(u32x4*)(O + ro + bj * HALF) = w; } }
    }
};
struct EpiResid {
    static constexpr bool PERM = false, HAS_MID = false;
    const float* X; const float* gate; float* O;
    __device__ __forceinline__ void operator()(const f32x4 (&acc)[2][2][4][2], const Unit& u, int wr, int wc, int fr, int fq) const {
        const int row0 = u.pm * BM + wr * 64 + fr, col0 = u.pn * BM + wc * 32 + 4 * fq; const int b = (u.pm * BM) / SEQ;
        f32x4 gv[2][2];
#pragma unroll
        for (int bj = 0; bj < 2; ++bj)
#pragma unroll
            for (int n = 0; n < 2; ++n) gv[bj][n] = *(const f32x4*)(gate + (size_t)b * NMOD * D + col0 + bj * HALF + n * 16);
#pragma unroll
        for (int ai = 0; ai < 2; ++ai)
#pragma unroll
            for (int m = 0; m < 4; ++m) { const size_t ro = (size_t)(row0 + ai * HALF + m * 16) * D + col0;
#pragma unroll
                for (int bj = 0; bj < 2; ++bj)
#pragma unroll
                    for (int n = 0; n < 2; ++n) { const f32x4 xv = *(const f32x4*)(X + ro + bj * HALF + n * 16);
                        *(f32x4*)(O + ro + bj * HALF + n * 16) = xv + gv[bj][n] * acc[ai][bj][m][n]; } }
    }
    __device__ __forceinline__ void mid(f32x4 (&)[2][2][4][2], const Unit&, int, int, int, int) const {}
};
struct EpiAct {
    static constexpr bool PERM = true, HAS_MID = false;
    bf16_t* ACT;
    __device__ __forceinline__ void operator()(const f32x4 (&acc)[2][2][4][2], const Unit& u, int wr, int wc, int fr, int fq) const {
        const int row0 = u.pm * BM + wr * 64 + fr, col0 = u.pn * 128 + wc * 32 + 8 * fq;
#pragma unroll
        for (int ai = 0; ai < 2; ++ai)
#pragma unroll
            for (int m = 0; m < 4; ++m) { float a[8];
#pragma unroll
                for (int n = 0; n < 2; ++n)
#pragma unroll
                    for (int j = 0; j < 4; ++j) { const float gg = acc[ai][0][m][n][j], uu = acc[ai][1][m][n][j]; a[4 * n + j] = gg / (1.f + __expf(-gg)) * uu; }
                u32x4 w; w.x = cvt_pk_bf16(a[0], a[1]); w.y = cvt_pk_bf16(a[2], a[3]); w.z = cvt_pk_bf16(a[4], a[5]); w.w = cvt_pk_bf16(a[6], a[7]);
                *(u32x4*)(ACT + (size_t)(row0 + ai * HALF + m * 16) * DFF + col0) = w; }
    }
    __device__ __forceinline__ void mid(f32x4 (&)[2][2][4][2], const Unit&, int, int, int, int) const {}
};
struct EpiDown {
    static constexpr bool PERM = true, HAS_MID = false;
    const int* list; const float* lw; const PG8_LAS int* tab; bf16_t* Y;
    __device__ __forceinline__ void operator()(const f32x4 (&acc)[2][2][4][2], const Unit& u, int wr, int wc, int fr, int fq) const {
        const int cnt = __builtin_amdgcn_readfirstlane(tab[32 + u.e]), col0 = u.pn * BM + wc * 32 + 8 * fq;
#pragma unroll
        for (int ai = 0; ai < 2; ++ai)
#pragma unroll
            for (int m = 0; m < 4; ++m) { const int pos = u.row0 + ai * HALF + wr * 64 + m * 16 + fr;
                if (pos < cnt) { const int ent = list[u.e * NTOK + pos]; const float w = lw[u.e * NTOK + pos];
                    bf16_t* dst = Y + ((size_t)(ent & 1) * NTOK + (size_t)(ent >> 1)) * D + col0;
#pragma unroll
                    for (int bj = 0; bj < 2; ++bj) { const f32x4 v0 = acc[ai][bj][m][0] * w, v1 = acc[ai][bj][m][1] * w;
                        u32x4 o; o.x = cvt_pk_bf16(v0[0], v0[1]); o.y = cvt_pk_bf16(v0[2], v0[3]); o.z = cvt_pk_bf16(v1[0], v1[1]); o.w = cvt_pk_bf16(v1[2], v1[3]);
                        *(u32x4*)(dst + bj * HALF) = o; } } }
    }
    __device__ __forceinline__ void mid(f32x4 (&)[2][2][4][2], const Unit&, int, int, int, int) const {}
};

template <class Epi, class Sched, bool ALIGN_EPI, bool GATHER>
__device__ __forceinline__ void gemm_phase(PG8_LAS unsigned char* lds, const Gemm g, const Sched& S, const Epi& E, const PG8_LAS int* gtab) {
    const int tid = threadIdx.x, wid = __builtin_amdgcn_readfirstlane(tid >> 6), lane = tid & 63, wr = wid >> 2, wc = wid & 3, fr = lane & 15, fq = lane >> 4;
    const int K = g.K, nt = K / BK;
    unsigned vA[2][2], voffB[2];
#pragma unroll
    for (int i = 0; i < 2; ++i) { int R, C; stage_rc(tid * 16 + i * 8192, R, C); const int Rb = Epi::PERM ? ((R & ~31) + perm32(R & 31)) : R;
        voffB[i] = (unsigned)(Rb * g.ldb + C) * 2u; vA[0][i] = (unsigned)(R * g.lda + C) * 2u; vA[1][i] = (unsigned)((R + HALF) * g.lda + C) * 2u; }
    const size_t kstep = (size_t)(BK * 2);
    const size_t hstepB = (size_t)HALF * g.ldb * 2;
    const unsigned ldsw = (unsigned)wid * 1024u;
    const int aoff = lds_byte(wr * 64 + fr, fq * 8), boff = lds_byte(wc * 32 + fr, fq * 8);
#define PG8_SA(b, h) (((b) * 2 + (h)) * HTB)
#define PG8_SB(b, h) ((4 + (b) * 2 + (h)) * HTB)
#define PG8_STAGE2(bufoff, gbase, o0, o1) do { \
        __builtin_amdgcn_global_load_lds((const unsigned*)((const char*)(gbase) + (o0)), (PG8_LAS unsigned*)(lds + (bufoff) + ldsw), 16, 0, 0); \
        __builtin_amdgcn_global_load_lds((const unsigned*)((const char*)(gbase) + (o1)), (PG8_LAS unsigned*)(lds + (bufoff) + ldsw + 8192), 16, 0, 0); } while (0)
#define PG8_STAGE_B(bufoff, gbase) PG8_STAGE2(bufoff, gbase, voffB[0], voffB[1])
#define PG8_STAGE_A(bufoff, gbase, h) PG8_STAGE2(bufoff, gbase, vA[h][0], vA[h][1])
#define PG8_STAGE_AX(bufoff, gbase, h) PG8_STAGE2(bufoff, gbase, xA[h][0], xA[h][1])
#define PG8_LDA(dst, b, h) do { _Pragma("unroll") for (int m = 0; m < 4; ++m) _Pragma("unroll") for (int k = 0; k < 2; ++k) dst[m][k] = *(const PG8_LAS bf16x8*)(lds + PG8_SA(b, h) + aoff + m * 2048 + k * 1024); } while (0)
#define PG8_LDB(dst, b, h) do { _Pragma("unroll") for (int n = 0; n < 2; ++n) _Pragma("unroll") for (int k = 0; k < 2; ++k) dst[n][k] = *(const PG8_LAS bf16x8*)(lds + PG8_SB(b, h) + boff + n * 2048 + k * 1024); } while (0)
#define PG8_MMA(ai, bj, At, Bt) do { __builtin_amdgcn_s_setprio(1); _Pragma("unroll") for (int m = 0; m < 4; ++m) _Pragma("unroll") for (int n = 0; n < 2; ++n) _Pragma("unroll") for (int k = 0; k < 2; ++k) \
        acc[ai][bj][m][n] = __builtin_amdgcn_mfma_f32_16x16x32_bf16(Bt[n][k], At[m][k], acc[ai][bj][m][n], 0, 0, 0); __builtin_amdgcn_s_setprio(0); } while (0)
#define PG8_WAIT_V(n) asm volatile("s_waitcnt vmcnt(" #n ")" ::: "memory")
#define PG8_WAIT_L(n) asm volatile("s_waitcnt lgkmcnt(" #n ")" ::: "memory")
#define PG8_BAR __builtin_amdgcn_s_barrier()
#define PG8_SCHED __builtin_amdgcn_sched_barrier(0)
    Unit cur, nxt; int ui = 0;
    if (!S.next(0, cur)) return;
    if constexpr (GATHER) {
#pragma unroll
        for (int h = 0; h < 2; ++h)
#pragma unroll
            for (int i = 0; i < 2; ++i) { int R, C; stage_rc(tid * 16 + i * 8192, R, C); vA[h][i] = (unsigned)gtab[R + h * HALF] * (unsigned)(g.lda * 2) + (unsigned)C * 2u; }
    }
    f32x4 acc[2][2][4][2];
#pragma unroll
    for (int a = 0; a < 2; ++a)
#pragma unroll
        for (int b = 0; b < 2; ++b)
#pragma unroll
            for (int m = 0; m < 4; ++m)
#pragma unroll
                for (int n = 0; n < 2; ++n) acc[a][b][m][n] = (f32x4){0.f, 0.f, 0.f, 0.f};
    bf16x8 At[4][2], B0[2][2], B1[2][2];
    const char* cA = S.abase(g, cur); const char* cB = S.bbase(g, cur);
    PG8_STAGE_B(PG8_SB(0, 0), cB); PG8_STAGE_B(PG8_SB(0, 1), cB + hstepB); PG8_STAGE_A(PG8_SA(0, 0), cA, 0); PG8_STAGE_A(PG8_SA(0, 1), cA, 1);
    if (wr == 1) PG8_BAR;
    PG8_WAIT_V(2); PG8_BAR;
    PG8_STAGE_B(PG8_SB(1, 0), cB + kstep); PG8_STAGE_A(PG8_SA(1, 0), cA + kstep, 0); PG8_STAGE_B(PG8_SB(1, 1), cB + hstepB + kstep);
    PG8_WAIT_V(6); PG8_BAR;
    for (;;) {
        const bool has_next = S.next(ui + 1, nxt);
        const char* nA = has_next ? S.abase(g, nxt) : cA; const char* nB = has_next ? S.bbase(g, nxt) : cB;
        for (int t = 0; t < nt; t += 2) {
            const bool last = (t == nt - 2);
            if constexpr (Epi::HAS_MID) { if (t == (nt >> 1)) { int fr_e = fr, fq_e = fq; asm volatile("" : "+v"(fr_e), "+v"(fq_e)); E.mid(acc, cur, wr, wc, fr_e, fq_e); } }
            const char* a1 = cA + (size_t)(t + 1) * kstep;
            const char* a2 = last ? nA : cA + (size_t)(t + 2) * kstep; const char* b2 = last ? nB : cB + (size_t)(t + 2) * kstep;
            const char* a3 = a2 + kstep; const char* b3 = b2 + kstep;
            unsigned xA[2][2];
#pragma unroll
            for (int h = 0; h < 2; ++h)
#pragma unroll
                for (int i = 0; i < 2; ++i) xA[h][i] = vA[h][i];
            if constexpr (GATHER) { if (last && has_next) {
#pragma unroll
                for (int h = 0; h < 2; ++h)
#pragma unroll
                    for (int i = 0; i < 2; ++i) { int R, C; stage_rc(tid * 16 + i * 8192, R, C); xA[h][i] = (unsigned)gtab[(ui + 1) * BM + R + h * HALF] * (unsigned)(g.lda * 2) + (unsigned)C * 2u; } } }
            PG8_LDB(B0, 0, 0); PG8_LDB(B1, 0, 1); PG8_SCHED; PG8_LDA(At, 0, 0); PG8_STAGE_A(PG8_SA(1, 1), a1, 1);
            PG8_WAIT_V(8); PG8_WAIT_L(0); PG8_BAR; PG8_MMA(0, 0, At, B0); PG8_MMA(0, 1, At, B1); PG8_BAR; PG8_SCHED;
            PG8_LDA(At, 0, 1); PG8_STAGE_B(PG8_SB(0, 0), b2); PG8_STAGE_B(PG8_SB(0, 1), b2 + hstepB); PG8_STAGE_AX(PG8_SA(0, 0), a2, 0);
            PG8_WAIT_V(8); PG8_WAIT_L(0); PG8_BAR; PG8_MMA(1, 0, At, B0); PG8_MMA(1, 1, At, B1); PG8_BAR; PG8_SCHED;
            PG8_LDB(B0, 1, 0); PG8_LDB(B1, 1, 1); PG8_SCHED; PG8_LDA(At, 1, 0); PG8_STAGE_AX(PG8_SA(0, 1), a2, 1);
            PG8_WAIT_V(8); PG8_WAIT_L(0); PG8_BAR; PG8_MMA(0, 0, At, B0); PG8_MMA(0, 1, At, B1); PG8_BAR; PG8_SCHED;
            PG8_LDA(At, 1, 1); PG8_STAGE_B(PG8_SB(1, 0), b3); PG8_STAGE_B(PG8_SB(1, 1), b3 + hstepB); PG8_STAGE_AX(PG8_SA(1, 0), a3, 0);
            PG8_WAIT_V(8); PG8_WAIT_L(0); PG8_BAR; PG8_MMA(1, 0, At, B0); PG8_MMA(1, 1, At, B1); PG8_BAR; PG8_SCHED;
        }
        if constexpr (ALIGN_EPI) { if (wr == 0) PG8_BAR; }
        { int fr_e = fr, fq_e = fq; asm volatile("" : "+v"(fr_e), "+v"(fq_e)); E(acc, cur, wr, wc, fr_e, fq_e); }
        if (!has_next) break;
#pragma unroll
        for (int a = 0; a < 2; ++a)
#pragma unroll
            for (int b = 0; b < 2; ++b)
#pragma unroll
                for (int m = 0; m < 4; ++m)
#pragma unroll
                    for (int n = 0; n < 2; ++n) acc[a][b][m][n] = (f32x4){0.f, 0.f, 0.f, 0.f};
        cur = nxt; cA = nA; cB = nB; ++ui;
        if constexpr (GATHER) {
#pragma unroll
            for (int h = 0; h < 2; ++h)
#pragma unroll
                for (int i = 0; i < 2; ++i) { int R, C; stage_rc(tid * 16 + i * 8192, R, C); vA[h][i] = (unsigned)gtab[ui * BM + R + h * HALF] * (unsigned)(g.lda * 2) + (unsigned)C * 2u; }
        }
        if constexpr (ALIGN_EPI) { if (wr == 1) PG8_BAR; }
    }
    PG8_WAIT_V(0);
    if constexpr (!ALIGN_EPI) { if (wr == 0) PG8_BAR; }
    PG8_BAR;
#undef PG8_SA
#undef PG8_SB
#undef PG8_STAGE2
#undef PG8_STAGE_A
#undef PG8_STAGE_AX
#undef PG8_STAGE_B
#undef PG8_LDA
#undef PG8_LDB
#undef PG8_MMA
#undef PG8_WAIT_V
#undef PG8_WAIT_L
#undef PG8_BAR
#undef PG8_SCHED
}
}

#define XB_TMO      128
#define XB_XCNT(j)  (256  + 64 * (j))
#define XB_XSUB(j)  (1280 + 64 * (j))
#define XB_XGEN(j)  (2304 + 64 * (j))
#define XB_TOP      3328
#define XB_TOPGEN   3392
#define XCD_BAR_WORDS 3456
#define XB_SPIN_CAP (1u << 18)

__device__ __forceinline__ unsigned xb_ld(unsigned* p)              { return __hip_atomic_load(p, __ATOMIC_RELAXED, __HIP_MEMORY_SCOPE_AGENT); }
__device__ __forceinline__ unsigned xb_add(unsigned* p, unsigned v) { return __hip_atomic_fetch_add(p, v, __ATOMIC_RELAXED, __HIP_MEMORY_SCOPE_AGENT); }
__device__ __forceinline__ unsigned xb_xcc_id() { return (unsigned)__builtin_amdgcn_s_getreg((3 << 11) | 20) & 0xFu; }
#define XB_SPIN(cond, bar) do { unsigned _sp = 0; while (cond) { __builtin_amdgcn_s_sleep(1); \
    if ((++_sp & 255u) == 0u) { if (xb_ld(&(bar)[XB_TMO])) break; if (_sp > XB_SPIN_CAP) { atomicAdd(&(bar)[XB_TMO], 1u); break; } } } } while (0)

struct XcdBarrier { unsigned* bar; unsigned x; volatile LAS unsigned* st; };

__device__ __forceinline__ XcdBarrier xcd_barrier_post(unsigned* bar, volatile LAS unsigned* st) {
    XcdBarrier b; b.bar = bar; b.x = xb_xcc_id(); b.st = st;
    if (threadIdx.x == 0) (void)xb_add(&bar[XB_XCNT(b.x)], 1u);
    return b;
}
__device__ __forceinline__ void xcd_barrier_complete(unsigned* bar, unsigned x, unsigned& nloc, unsigned& nx) {
    const unsigned G = gridDim.x * gridDim.y * gridDim.z;
    unsigned sum, cnt, mine, sp = 0u;
    for (;;) {
        sum = 0u; cnt = 0u; mine = 0u;
#pragma unroll
        for (unsigned j = 0; j < 16; ++j) { const unsigned c = xb_ld(&bar[XB_XCNT(j)]); sum += c; cnt += (c > 0u) ? 1u : 0u; mine = (j == x) ? c : mine; }
        if (sum == G) break;
        __builtin_amdgcn_s_sleep(1);
        if ((++sp & 255u) == 0u) { if (xb_ld(&bar[XB_TMO])) break; if (sp > XB_SPIN_CAP) { atomicAdd(&bar[XB_TMO], 1u); break; } }
    }
    nloc = mine > 0u ? mine : 1u; nx = cnt > 0u ? cnt : 1u;
}
__device__ __forceinline__ void xcd_barrier(const XcdBarrier& b) {
    asm volatile("s_waitcnt vmcnt(0)" ::: "memory");
    __syncthreads();
    if (threadIdx.x == 0) {
        unsigned* bar = b.bar;
        __builtin_amdgcn_s_waitcnt(0);
        unsigned nloc = b.st[0], nx = b.st[1];
        if (nloc == 0u) { xcd_barrier_complete(bar, b.x, nloc, nx); b.st[0] = nloc; b.st[1] = nx; }
        const unsigned old = xb_add(&bar[XB_XSUB(b.x)], 1u);
        const unsigned gen = old / nloc;
        if (old + 1u == (gen + 1u) * nloc) {
            __builtin_amdgcn_fence(__ATOMIC_RELEASE, "agent");
            asm volatile("s_waitcnt vmcnt(0)" ::: "memory");
            const unsigned og = xb_add(&bar[XB_TOP], 1u);
            const unsigned tg = og / nx;
            if (og + 1u == (tg + 1u) * nx) xb_add(&bar[XB_TOPGEN], 1u);
            else XB_SPIN(xb_ld(&bar[XB_TOPGEN]) == tg, bar);
            __builtin_amdgcn_fence(__ATOMIC_ACQUIRE, "agent");
            xb_add(&bar[XB_XGEN(b.x)], 1u);
            asm volatile("s_waitcnt vmcnt(0)" ::: "memory");
        } else {
            XB_SPIN(xb_ld(&bar[XB_XGEN(b.x)]) == gen, bar);
            __builtin_amdgcn_fence(__ATOMIC_ACQUIRE, "agent");
            asm volatile("s_waitcnt vmcnt(0)" ::: "memory");
        }
    }
    __syncthreads();
}

struct Frame {
    LAS unsigned char* lds;
    int tid, lane, wave, vcu, G;
};
__device__ __forceinline__ float wave_sum(float v) {
#pragma unroll
    for (int o = 1; o < 64; o <<= 1) v += __shfl_xor(v, o);
    return v;
}
__device__ __forceinline__ float sigmoid_f(float v) { return 1.f / (1.f + __expf(-v)); }
__device__ __forceinline__ float log_sigmoid_f(float v) { return fminf(v, 0.f) - log1pf(expf(-fabsf(v))); }

__device__ __forceinline__ void tr_item(const float* W, int ldw, int k0, int nsrc, bf16* WT, int ldt, int drow, int dk, LAS float* scr, int lane) {
#pragma unroll 8
    for (int i = 0; i < 32; ++i) { const int kk = 2 * i + (lane >> 5); scr[kk * 33 + (lane & 31)] = W[(size_t)(k0 + kk) * ldw + nsrc + (lane & 31)]; }
    LDS_WAIT(); asm volatile("" ::: "memory");
    const int c = lane & 7;
#pragma unroll
    for (int j = 0; j < 4; ++j) { const int n = (lane >> 3) + 8 * j; const LAS float* s = scr + (8 * c) * 33 + n;
        v4u o; o.x = pk2(s[0 * 33], s[1 * 33]); o.y = pk2(s[2 * 33], s[3 * 33]); o.z = pk2(s[4 * 33], s[5 * 33]); o.w = pk2(s[6 * 33], s[7 * 33]);
        *(GAS v4u*)(WT + (size_t)(drow + n) * ldt + dk + k0 + 8 * c) = o; }
    LDS_WAIT(); asm volatile("" ::: "memory");
}
__device__ __forceinline__ int win_src_col(int n0) {
    if (n0 < 512) return n0;
    if (n0 < 1024) return 1544 + (n0 - 512);
    if (n0 < 1536) return 512 + (n0 - 1024);
    if (n0 < 2048) return 2056 + (n0 - 1536);
    if (n0 < 2560) return 1024 + (n0 - 2048);
    if (n0 < 3072) return 2568 + (n0 - 2560);
    if (n0 < 4096) return 3080 + (n0 - 3072);
    return 4104 + (n0 - 4096);
}

struct Args { const float* in[19]; float* out; unsigned char* ws; int ph_lo, ph_hi; };

__global__ void __launch_bounds__(NWAVES * 64, 2) fwd(Args args) {
    extern __shared__ __attribute__((aligned(16))) unsigned char lds_raw[];
    Frame F;
    F.lds = (LAS unsigned char*)lds_raw;
    F.tid = threadIdx.x; F.lane = F.tid & 63; F.wave = __builtin_amdgcn_readfirstlane(F.tid >> 6);
    F.G = gridDim.x; { const int bx = blockIdx.x; F.vcu = (F.G % 8 == 0) ? (bx % 8) * (F.G / 8) + bx / 8 : bx; }
    unsigned char* ws = args.ws;
    unsigned* ctl = (unsigned*)(ws + WS_CTL);
    volatile LAS unsigned* MISC = (volatile LAS unsigned*)(F.lds + MISC_OFF);
    for (int u = F.tid; u < 256; u += NWAVES * 64) ((LAS unsigned*)(F.lds + MISC_OFF))[u] = 0u;
    __syncthreads();
    XcdBarrier bar = xcd_barrier_post(ctl + CW_BAR, MISC + 8);
    const int lo = args.ph_lo, hi = args.ph_hi;
#define IN(k) (lo <= (k) && (k) < hi)
#define BOTH(k) (IN(k) && IN((k) + 1))
    const int tid = F.tid, lane = F.lane, wave = F.wave;
    const int gw = F.vcu * NWAVES + wave, NGW = F.G * NWAVES;
    float* mod = (float*)(ws + WS_MOD);
    float* LOGF = (float*)(ws + WS_LOGF);
    float* FC = (float*)(ws + WS_F);
    bf16* WIN = (bf16*)(ws + WS_WIN); bf16* WBR = (bf16*)(ws + WS_WBR); bf16* WOUT = (bf16*)(ws + WS_WOUT); bf16* WGU = (bf16*)(ws + WS_WGU); bf16* WD = (bf16*)(ws + WS_WD);
    bf16* XN = (bf16*)(ws + WS_XN); bf16* QB = (bf16*)(ws + WS_Q); bf16* KB = (bf16*)(ws + WS_K); bf16* VB = (bf16*)(ws + WS_V); bf16* GAB = (bf16*)(ws + WS_GA); bf16* GBB = (bf16*)(ws + WS_GB);
    bf16* ACT = (bf16*)(ws + WS_ACT); bf16* YB = (bf16*)(ws + WS_Y);
    int* LIST = (int*)(ws + WS_LIST); float* LW = (float*)(ws + WS_LW);
    const float* x = args.in[0];

    if (IN(0)) {
        LAS float* cs = (LAS float*)F.lds;
        LAS float* red = (LAS float*)(F.lds + 32768);
        for (int i = tid; i < BATCH * D; i += NWAVES * 64) { const float v = args.in[1][i]; cs[i] = v / (1.f + expf(-v)); }
        __syncthreads();
        if (F.vcu < 192) {
            const int cc = tid & 31, ks = tid >> 5, col = F.vcu * 32 + cc;
            float a[8];
#pragma unroll
            for (int b = 0; b < 8; ++b) a[b] = 0.f;
            const float* wp = args.in[2] + col;
            for (int k = ks * 64; k < ks * 64 + 64; ++k) { const float w = wp[(size_t)k * (NMOD * D)];
#pragma unroll
                for (int b = 0; b < 8; ++b) a[b] += cs[b * D + k] * w; }
#pragma unroll
            for (int b = 0; b < 8; ++b) red[(ks * 8 + b) * 32 + cc] = a[b];
            __syncthreads();
            if (tid < 256) { const int b = tid >> 5; float s = 0.f;
#pragma unroll
                for (int q = 0; q < 16; ++q) s += red[(q * 8 + b) * 32 + cc];
                mod[b * (NMOD * D) + F.vcu * 32 + cc] = s + args.in[3][F.vcu * 32 + cc]; }
        }
        __syncthreads();
        LAS float* scr = (LAS float*)(F.lds + wave * 16384);
        constexpr int I_WIN = 16 * 160, I_BR = 8 * 32, I_OUT = 16 * 32, I_G = 16 * 256, I_D = 16 * 256;
        constexpr int NITEMS = I_WIN + 2 * I_BR + I_OUT + 2 * I_G + I_D;
        for (int it = gw; it < NITEMS; it += NGW) {
            int r = it;
            if (r < I_WIN) { const int kb = r / 160, nb = r % 160; tr_item(args.in[5], NIN, 64 * kb, win_src_col(32 * nb), WIN, D, 32 * nb, 0, scr, lane); continue; } r -= I_WIN;
            if (r < I_BR) { const int kb = r / 32, nb = r % 32; tr_item(args.in[7], D, 64 * kb, 32 * nb, WBR, D, 32 * nb, 0, scr, lane); continue; } r -= I_BR;
            if (r < I_BR) { const int kb = r / 32, nb = r % 32; tr_item(args.in[8], D, 64 * kb, 32 * nb, WBR, D, 32 * nb, 512, scr, lane); continue; } r -= I_BR;
            if (r < I_OUT) { const int kb = r / 32, nb = r % 32; tr_item(args.in[9], D, 64 * kb, 32 * nb, WOUT, D, 32 * nb, 0, scr, lane); continue; } r -= I_OUT;
            if (r < 2 * I_G) { const int up = r / I_G; r -= up * I_G; const int e = r / 256, q = r % 256, kb = q / 16, nb = q % 16, n0 = 32 * nb;
                tr_item(args.in[15 + up] + (size_t)e * D * DFF, DFF, 64 * kb, n0, WGU + (size_t)e * D * D, D, 256 * (n0 / 128) + (n0 % 128) + 128 * up, 0, scr, lane); continue; } r -= 2 * I_G;
            { const int e = r / 256, q = r % 256, kb = q / 32, nb = q % 32; tr_item(args.in[17] + (size_t)e * DFF * D, D, 64 * kb, 32 * nb, WD + (size_t)e * D * DFF, DFF, 32 * nb, 0, scr, lane); }
        }
        if (BOTH(0)) xcd_barrier(bar);
    }

    if (IN(1)) {
        for (int rb = F.vcu; rb < NTOK / 128; rb += F.G) {
        const int b = rb / 32;
        f32x4 wfa[16], wfb[16];
#pragma unroll
        for (int j = 0; j < 4; ++j)
#pragma unroll
            for (int c = 0; c < 4; ++c) { const int k = 4 * lane + 256 * j + c; wfa[4 * j + c] = *(const f32x4*)(args.in[5] + (size_t)k * NIN + 1536); wfb[4 * j + c] = *(const f32x4*)(args.in[5] + (size_t)k * NIN + 1540); }
        const float bfg = args.in[6][lane & 7];
        {
        for (int r = wave; r < 128; r += NWAVES) {
            const int m = rb * 128 + r;
            const GAS f32x4* xr = (const GAS f32x4*)(x + (size_t)m * D) + lane;
            f32x4 v[4]; float ss = 0.f;
#pragma unroll
            for (int j = 0; j < 4; ++j) { v[j] = xr[64 * j]; ss += (v[j].x * v[j].x + v[j].y * v[j].y) + (v[j].z * v[j].z + v[j].w * v[j].w); }
            const float rstd = 1.f / sqrtf(wave_sum(ss) * (1.f / D) + RMS_EPS);
            f32x4 fa0 = (f32x4){0.f, 0.f, 0.f, 0.f}, fa1 = fa0;
            GAS unsigned long long* o8 = (GAS unsigned long long*)(XN + (size_t)m * D) + lane;
#pragma unroll
            for (int j = 0; j < 4; ++j) { const int k = 4 * lane + 256 * j; const f32x4 g1 = *(const f32x4*)(args.in[4] + k), sc = *(const f32x4*)(mod + b * NMOD * D + D + k), sh = *(const f32x4*)(mod + b * NMOD * D + k);
                const f32x4 h = v[j] * rstd * (g1 * (sc + 1.f)) + sh;
                o8[64 * j] = (unsigned long long)pk2(h.x, h.y) | ((unsigned long long)pk2(h.z, h.w) << 32);
                fa0 += h.x * wfa[4 * j] + h.y * wfa[4 * j + 1] + h.z * wfa[4 * j + 2] + h.w * wfa[4 * j + 3];
                fa1 += h.x * wfb[4 * j] + h.y * wfb[4 * j + 1] + h.z * wfb[4 * j + 2] + h.w * wfb[4 * j + 3]; }
            float f[8] = {fa0.x, fa0.y, fa0.z, fa0.w, fa1.x, fa1.y, fa1.z, fa1.w};
#pragma unroll
            for (int q = 0; q < 8; ++q) f[q] = wave_sum(f[q]);
            const int hq = lane & 7; float val = f[0];
#pragma unroll
            for (int q = 1; q < 8; ++q) val = (hq == q) ? f[q] : val;
            if (lane < 8) LOGF[(size_t)(b * 8 + hq) * SEQ + (m % SEQ)] = log_sigmoid_f(val + bfg);
        }
        }
        }
        if (BOTH(1)) xcd_barrier(bar);
    }

    if (IN(2)) {
        for (int bh = F.vcu; bh < 64; bh += F.G) {
            LAS float* wt = (LAS float*)F.lds;
            const float* src = LOGF + (size_t)bh * SEQ + tid * 8; float* dst = FC + (size_t)bh * SEQ + tid * 8;
            const f32x4 a = *(const f32x4*)src, c = *(const f32x4*)(src + 4);
            float p[8]; p[0] = a.x; p[1] = p[0] + a.y; p[2] = p[1] + a.z; p[3] = p[2] + a.w; p[4] = p[3] + c.x; p[5] = p[4] + c.y; p[6] = p[5] + c.z; p[7] = p[6] + c.w;
            float incl = p[7];
#pragma unroll
            for (int o = 1; o < 64; o <<= 1) { const float t = __shfl_up(incl, o); if (lane >= o) incl += t; }
            if (lane == 63) wt[wave] = incl;
            __syncthreads();
            float base = incl - p[7];
            for (int w = 0; w < wave; ++w) base += wt[w];
            *(f32x4*)dst = (f32x4){p[0] + base, p[1] + base, p[2] + base, p[3] + base}; *(f32x4*)(dst + 4) = (f32x4){p[4] + base, p[5] + base, p[6] + base, p[7] + base};
            __syncthreads();
        }
        pg8::Gemm g{XN, WIN, D, D, D}; pg8::StaticOrder S; S.init(NTOK, NP1, F.G, (int)blockIdx.x);
        pg8::EpiSplit E{QB, D, D, (size_t)(WS_K - WS_Q) / 2, C2};
        pg8::gemm_phase<pg8::EpiSplit, pg8::StaticOrder, true, false>(F.lds, g, S, E, nullptr);
        if (BOTH(2)) xcd_barrier(bar);
    }

    if (IN(3)) {
        for (int i = 0; ; ++i) {
            const int j = gw + NGW * i; if (j >= 8192) break;
            const int bh = j >> 6; int tb = j & 63; if (i & 1) tb = 63 - tb;
            const int type = bh >> 6, b = (bh >> 3) & 7, h = bh & 7, hc = type * 512 + h * 64;
            const int t = tb * 64 + lane, tmax = tb * 64 + 63;
            const bf16* qp = QB + ((size_t)(b * SEQ + t)) * D + hc;
            float q[64], o[64];
#pragma unroll
            for (int d = 0; d < 64; d += 8) { const v4u w = *(const v4u*)(qp + d);
#pragma unroll
                for (int e = 0; e < 4; ++e) { q[d + 2 * e] = bflo(w[e]); q[d + 2 * e + 1] = bfhi(w[e]); } }
#pragma unroll
            for (int d = 0; d < 64; ++d) o[d] = 0.f;
            const bf16* kbase = KB + (size_t)(b * SEQ) * D + hc; const bf16* vbase = VB + (size_t)(b * SEQ) * D + hc;
            if (type == 0) {
                const float* Fr = FC + (size_t)(b * 8 + h) * SEQ; const float Fq = Fr[t];
                float mx = -1e30f, l = 0.f;
                for (int s = 0; s <= tmax; ++s) {
                    const bf16* kr = kbase + (size_t)s * D; const bf16* vr = vbase + (size_t)s * D;
                    float dot = 0.f;
#pragma unroll
                    for (int d = 0; d < 64; d += 8) { const v4u w = *(const v4u*)(kr + d);
#pragma unroll
                        for (int e = 0; e < 4; ++e) { dot += q[d + 2 * e] * bflo(w[e]); dot += q[d + 2 * e + 1] * bfhi(w[e]); } }
                    const float lg = dot + (Fq - Fr[s]) * LOG2E;
                    if (s <= t) {
                        const float mn = fmaxf(mx, lg), sc = exp2f(mx - mn), p = exp2f(lg - mn); l = l * sc + p; mx = mn;
#pragma unroll
                        for (int d = 0; d < 64; d += 8) { const v4u w = *(const v4u*)(vr + d);
#pragma unroll
                            for (int e = 0; e < 4; ++e) { o[d + 2 * e] = o[d + 2 * e] * sc + p * bflo(w[e]); o[d + 2 * e + 1] = o[d + 2 * e + 1] * sc + p * bfhi(w[e]); } }
                    }
                }
                const float il = 1.f / l;
#pragma unroll
                for (int d = 0; d < 64; ++d) o[d] *= il;
            } else {
                float carry = 0.f;
                for (int s = tmax - 1; s >= 0; --s) {
                    const bf16* kr = kbase + (size_t)s * D; const bf16* vr = vbase + (size_t)s * D;
                    float z = 0.f;
#pragma unroll
                    for (int d = 0; d < 64; d += 8) { const v4u w = *(const v4u*)(kr + d);
#pragma unroll
                        for (int e = 0; e < 4; ++e) { z += q[d + 2 * e] * bflo(w[e]); z += q[d + 2 * e + 1] * bfhi(w[e]); } }
                    if (s < t) {
                        const float lb = fminf(z, 0.f) - log2f(1.f + exp2f(-fabsf(z)));
                        const float p = exp2f(lb + carry); carry += lb - z;
#pragma unroll
                        for (int d = 0; d < 64; d += 8) { const v4u w = *(const v4u*)(vr + d);
#pragma unroll
                            for (int e = 0; e < 4; ++e) { o[d + 2 * e] += p * bflo(w[e]); o[d + 2 * e + 1] += p * bfhi(w[e]); } }
                    }
                }
            }
            bf16* op = QB + ((size_t)(b * SEQ + t)) * D + hc;
#pragma unroll
            for (int d = 0; d < 64; d += 8) { v4u w; w.x = pk2(o[d], o[d + 1]); w.y = pk2(o[d + 2], o[d + 3]); w.z = pk2(o[d + 4], o[d + 5]); w.w = pk2(o[d + 6], o[d + 7]); *(v4u*)(op + d) = w; }
        }
        if (BOTH(3)) xcd_barrier(bar);
    }

    if (IN(4)) {
        pg8::Gemm g{QB, WBR, D, D, D}; pg8::StaticOrder S; S.init(NTOK, D, F.G, (int)blockIdx.x);
        pg8::EpiMerge E{GAB, GBB, KB};
        pg8::gemm_phase<pg8::EpiMerge, pg8::StaticOrder, true, false>(F.lds, g, S, E, nullptr);
        if (BOTH(4)) xcd_barrier(bar);
    }

    if (IN(5)) {
        pg8::Gemm g{KB, WOUT, D, D, D}; pg8::StaticOrder S; S.init(NTOK, D, F.G, (int)blockIdx.x);
        pg8::EpiResid E{x, mod + 2 * D, args.out};
        pg8::gemm_phase<pg8::EpiResid, pg8::StaticOrder, true, false>(F.lds, g, S, E, nullptr);
        if (BOTH(5)) xcd_barrier(bar);
    }

    if (IN(6)) {
        LAS float* wr = (LAS float*)F.lds;
        LAS float* rscr = (LAS float*)(F.lds + 81920) + wave * 128;
        LAS int* selE = (LAS int*)(F.lds + 81920 + 8 * 512);
        LAS float* selW = (LAS float*)(F.lds + 81920 + 8 * 512 + 512);
        LAS int* lcnt = (LAS int*)(F.lds + 81920 + 8 * 512 + 512 + 1024);
        LAS int* lpos = lcnt + 32;
        for (int k = tid; k < D; k += NWAVES * 64) {
            const f32x4 g4 = *(const f32x4*)(args.in[11] + (size_t)k * 4);
            wr[0 * D + k] = g4.x; wr[1 * D + k] = g4.y; wr[2 * D + k] = g4.z; wr[3 * D + k] = g4.w;
#pragma unroll
            for (int q = 0; q < 4; ++q) { const f32x4 e4 = *(const f32x4*)(args.in[13] + (size_t)k * 16 + 4 * q);
                wr[(4 + 4 * q) * D + k] = e4.x; wr[(5 + 4 * q) * D + k] = e4.y; wr[(6 + 4 * q) * D + k] = e4.z; wr[(7 + 4 * q) * D + k] = e4.w; }
        }
        for (int rb = F.vcu; rb < NTOK / 128; rb += F.G) {
        if (tid < 32) lcnt[tid] = 0;
        __syncthreads();
        const int b = rb / 32;
        f32x4 gs[4], sh[4];
#pragma unroll
        for (int j = 0; j < 4; ++j) { const int k = 4 * lane + 256 * j; const f32x4 g2 = *(const f32x4*)(args.in[10] + k), sc = *(const f32x4*)(mod + b * NMOD * D + 4 * D + k); sh[j] = *(const f32x4*)(mod + b * NMOD * D + 3 * D + k); gs[j] = g2 * (sc + 1.f); }
        for (int rg = 0; rg < 4; ++rg) {
            const int rl0 = wave * 16 + rg * 4;
            f32x4 hv[4][4];
#pragma unroll
            for (int r = 0; r < 4; ++r) { const int m = rb * 128 + rl0 + r;
                const GAS f32x4* xr = (const GAS f32x4*)(args.out + (size_t)m * D) + lane; float ss = 0.f;
#pragma unroll
                for (int j = 0; j < 4; ++j) { hv[r][j] = xr[64 * j]; ss += (hv[r][j].x * hv[r][j].x + hv[r][j].y * hv[r][j].y) + (hv[r][j].z * hv[r][j].z + hv[r][j].w * hv[r][j].w); }
                const float rstd = 1.f / sqrtf(wave_sum(ss) * (1.f / D) + RMS_EPS);
                GAS unsigned long long* o8 = (GAS unsigned long long*)(XN + (size_t)m * D) + lane;
#pragma unroll
                for (int j = 0; j < 4; ++j) { hv[r][j] = hv[r][j] * rstd * gs[j] + sh[j];
                    o8[64 * j] = (unsigned long long)pk2(hv[r][j].x, hv[r][j].y) | ((unsigned long long)pk2(hv[r][j].z, hv[r][j].w) << 32); } }
            float a[80];
#pragma unroll
            for (int i = 0; i < 80; ++i) a[i] = 0.f;
#pragma unroll
            for (int qq = 0; qq < 20; ++qq)
#pragma unroll
                for (int j = 0; j < 4; ++j) { const f32x4 w = *(const LAS f32x4*)(wr + qq * D + 256 * j + 4 * lane);
#pragma unroll
                    for (int r = 0; r < 4; ++r) { const int idx = 16 * (qq >> 2) + 4 * (qq & 3) + r;
                        a[idx] += (hv[r][j].x * w.x + hv[r][j].y * w.y) + (hv[r][j].z * w.z + hv[r][j].w * w.w); } }
            float b40[40], b20[20], b10[10], b5[5];
            { const bool up = (lane & 32) != 0;
#pragma unroll
              for (int i = 0; i < 5; ++i)
#pragma unroll
                for (int c = 0; c < 8; ++c) { const float lo_ = a[16 * i + c], hi_ = a[16 * i + c + 8]; const float snd = up ? lo_ : hi_, kp = up ? hi_ : lo_; b40[8 * i + c] = kp + __shfl_xor(snd, 32); } }
            { const bool up = (lane & 16) != 0;
#pragma unroll
              for (int i = 0; i < 5; ++i)
#pragma unroll
                for (int c = 0; c < 4; ++c) { const float lo_ = b40[8 * i + c], hi_ = b40[8 * i + c + 4]; const float snd = up ? lo_ : hi_, kp = up ? hi_ : lo_; b20[4 * i + c] = kp + __shfl_xor(snd, 16); } }
            { const bool up = (lane & 8) != 0;
#pragma unroll
              for (int i = 0; i < 5; ++i)
#pragma unroll
                for (int c = 0; c < 2; ++c) { const float lo_ = b20[4 * i + c], hi_ = b20[4 * i + c + 2]; const float snd = up ? lo_ : hi_, kp = up ? hi_ : lo_; b10[2 * i + c] = kp + __shfl_xor(snd, 8); } }
            { const bool up = (lane & 4) != 0;
#pragma unroll
              for (int i = 0; i < 5; ++i) { const float lo_ = b10[2 * i], hi_ = b10[2 * i + 1]; const float snd = up ? lo_ : hi_, kp = up ? hi_ : lo_; b5[i] = kp + __shfl_xor(snd, 4); } }
#pragma unroll
            for (int i = 0; i < 5; ++i) { b5[i] += __shfl_xor(b5[i], 1); b5[i] += __shfl_xor(b5[i], 2); }
            { const int c = (lane >> 2) & 15;
              if ((lane & 3) == 0) {
#pragma unroll
                  for (int i = 0; i < 5; ++i) rscr[(c & 3) * 20 + 4 * i + (c >> 2)] = b5[i]; } }
            LDS_WAIT(); asm volatile("" ::: "memory");
            if (lane < 4) {
                float lg[20];
#pragma unroll
                for (int i = 0; i < 20; ++i) lg[i] = rscr[lane * 20 + i];
#pragma unroll
                for (int i = 0; i < 4; ++i) lg[i] += args.in[12][i];
#pragma unroll
                for (int i = 0; i < 16; ++i) lg[4 + i] += args.in[14][i];
                int gi = 0; float gm = lg[0];
#pragma unroll
                for (int i = 1; i < 4; ++i) if (lg[i] > gm) { gm = lg[i]; gi = i; }
                float gsum = 0.f;
#pragma unroll
                for (int i = 0; i < 4; ++i) gsum += expf(lg[i] - gm);
                const float gp = 1.f / gsum;
                float es[4];
#pragma unroll
                for (int i = 0; i < 4; ++i) es[i] = (gi == 0) ? lg[4 + i] : (gi == 1) ? lg[8 + i] : (gi == 2) ? lg[12 + i] : lg[16 + i];
                int i1 = 0; float m1 = es[0];
#pragma unroll
                for (int i = 1; i < 4; ++i) if (es[i] > m1) { m1 = es[i]; i1 = i; }
                int i2 = -1; float m2 = -3.0e38f;
#pragma unroll
                for (int i = 0; i < 4; ++i) if (i != i1 && es[i] > m2) { m2 = es[i]; i2 = i; }
                const float p2 = expf(m2 - m1), inv = 1.f / (1.f + p2);
                const int rl = rl0 + lane;
                selE[rl] = (gi * 4 + i1) | ((gi * 4 + i2) << 8); selW[2 * rl] = gp * inv; selW[2 * rl + 1] = gp * p2 * inv;
            }
            LDS_WAIT(); asm volatile("" ::: "memory");
        }
        __syncthreads();
        int my_e = 0;
        if (tid < 256) { const int se = selE[tid >> 1]; my_e = (tid & 1) ? (se >> 8) & 255 : se & 255; lpos[tid] = __hip_atomic_fetch_add(&lcnt[my_e], 1, __ATOMIC_RELAXED, __HIP_MEMORY_SCOPE_WORKGROUP); }
        __syncthreads();
        if (tid < 16) lcnt[16 + tid] = (int)__hip_atomic_fetch_add(ctl + CW_CNT + 64 * tid, (unsigned)lcnt[tid], __ATOMIC_RELAXED, __HIP_MEMORY_SCOPE_AGENT);
        __syncthreads();
        if (tid < 256) { const int pos = lcnt[16 + my_e] + lpos[tid]; LIST[my_e * NTOK + pos] = (rb * 128 + (tid >> 1)) * 2 + (tid & 1); LW[my_e * NTOK + pos] = selW[tid]; }
        __syncthreads();
        }
        if (BOTH(6)) xcd_barrier(bar);
    }

    LAS int* tab = (LAS int*)(F.lds + TAB_OFF);
    LAS int* gtab = (LAS int*)(F.lds + TAB_OFF + 256);
    if (IN(7) || IN(8)) {
        if (tid == 0) { int acc_t = 0;
            for (int e = 0; e < 16; ++e) { const int c = (int)__hip_atomic_load(ctl + CW_CNT + 64 * e, __ATOMIC_RELAXED, __HIP_MEMORY_SCOPE_AGENT); tab[e] = acc_t; tab[32 + e] = c; acc_t += (c + 255) >> 8; }
            tab[16] = acc_t; }
        __syncthreads();
    }
    if (IN(7)) {
        pg8::MoeOrder S{tab, F.G, F.vcu, (size_t)D * D * 2, true};
        { pg8::Unit u;
          for (int i = 0; i < 14; ++i) { if (!S.next(i, u)) break;
              if (tid < 256) { const int pos = u.row0 + tid; gtab[i * 256 + tid] = (pos < tab[32 + u.e]) ? (LIST[u.e * NTOK + pos] >> 1) : 0; } } }
        __syncthreads();
        pg8::Gemm g{XN, WGU, D, D, D};
        pg8::EpiAct E{ACT};
        pg8::gemm_phase<pg8::EpiAct, pg8::MoeOrder, true, true>(F.lds, g, S, E, gtab);
        if (BOTH(7)) xcd_barrier(bar);
    }
    if (IN(8)) {
        pg8::MoeOrder S{tab, F.G, F.vcu, (size_t)D * DFF * 2, false};
        pg8::Gemm g{ACT, WD, DFF, DFF, DFF};
        pg8::EpiDown E{LIST, LW, tab, YB};
        pg8::gemm_phase<pg8::EpiDown, pg8::MoeOrder, true, false>(F.lds, g, S, E, nullptr);
        if (BOTH(8)) xcd_barrier(bar);
    }
    if (IN(9)) {
        for (int rb = F.vcu; rb < NTOK / 128; rb += F.G) {
        const int b = rb / 32;
        f32x4 g2[4], fg[4];
#pragma unroll
        for (int j = 0; j < 4; ++j) { const int k = 4 * lane + 256 * j; g2[j] = *(const f32x4*)(mod + b * NMOD * D + 5 * D + k); fg[j] = *(const f32x4*)(args.in[18] + k); }
        {
        for (int r = wave; r < 128; r += NWAVES) {
            const int m = rb * 128 + r;
            GAS f32x4* xr = (GAS f32x4*)(args.out + (size_t)m * D) + lane;
            const GAS v2u* y0 = (const GAS v2u*)(YB + (size_t)m * D) + lane; const GAS v2u* y1 = (const GAS v2u*)(YB + (size_t)(NTOK + m) * D) + lane;
            f32x4 v[4]; float ss = 0.f;
#pragma unroll
            for (int j = 0; j < 4; ++j) { const v2u a = y0[64 * j], c = y1[64 * j];
                const f32x4 ys = (f32x4){bflo(a.x) + bflo(c.x), bfhi(a.x) + bfhi(c.x), bflo(a.y) + bflo(c.y), bfhi(a.y) + bfhi(c.y)};
                v[j] = xr[64 * j] + g2[j] * ys; ss += (v[j].x * v[j].x + v[j].y * v[j].y) + (v[j].z * v[j].z + v[j].w * v[j].w); }
            const float rstd = 1.f / sqrtf(wave_sum(ss) * (1.f / D) + RMS_EPS);
#pragma unroll
            for (int j = 0; j < 4; ++j) xr[64 * j] = v[j] * rstd * fg[j];
        }
        }
        }
    }
#undef IN
#undef BOTH
}

extern "C" void kernel_launch(void* const* d_in, const int* in_sizes, int n_in, void* d_out, int out_size, void* d_ws, size_t ws_size, hipStream_t stream) {
    static int grid = 0;
    if (grid == 0) {
        if (n_in != 19 || in_sizes[0] != NTOK * D || out_size != NTOK * D || ws_size < WS_END) { fprintf(stderr, "kernel_launch: unexpected problem shape (n_in %d, ws %zu)\n", n_in, ws_size); grid = -1; return; }
        int dev = 0, cus = 0, per_cu = 0;
        if (hipGetDevice(&dev) != hipSuccess || hipDeviceGetAttribute(&cus, hipDeviceAttributeMultiprocessorCount, dev) != hipSuccess) { grid = -1; return; }
        if (hipFuncSetAttribute((const void*)fwd, hipFuncAttributeMaxDynamicSharedMemorySize, LDS_BYTES) != hipSuccess) { grid = -1; return; }
        if (hipOccupancyMaxActiveBlocksPerMultiprocessor(&per_cu, (const void*)fwd, NWAVES * 64, LDS_BYTES) != hipSuccess || per_cu < 1) { fprintf(stderr, "kernel_launch: occupancy query reports %d\n", per_cu); }
        (void)hipGetLastError();
        grid = cus;
    }
    if (grid < 0) return;
    if (hipMemsetAsync((char*)d_ws + WS_CTL, 0, CTL_ZERO_BYTES, stream) != hipSuccess) return;
    Args a{};
    for (int i = 0; i < 19; ++i) a.in[i] = (const float*)d_in[i];
    a.out = (float*)d_out; a.ws = (unsigned char*)d_ws; a.ph_lo = 0; a.ph_hi = 10;
    hipLaunchKernelGGL(fwd, dim3(grid), dim3(NWAVES * 64), LDS_BYTES, stream, a);
}
```

```cpp
#include <hip/hip_runtime.h>
#include <cstdio>
#include <cstdint>

#define GAS __attribute__((address_space(1)))
#define LAS __attribute__((address_space(3)))
typedef unsigned short bf16;
typedef unsigned v4u __attribute__((ext_vector_type(4)));
typedef unsigned v2u __attribute__((ext_vector_type(2)));
typedef float f32x4 __attribute__((ext_vector_type(4)));
typedef float f32x2 __attribute__((ext_vector_type(2)));
typedef short bf16x8 __attribute__((ext_vector_type(8)));

constexpr int BATCH = 8, SEQ = 4096, D = 1024, NTOK = BATCH * SEQ, HD = 64;
constexpr int NIN = 5128, NP1 = 5120, NE = 16, DFF = 512, NMOD = 6;
constexpr float RMS_EPS = 1e-6f;
constexpr float LOG2E = 1.4426950408889634f;
constexpr float C2 = 0.125f * 1.4426950408889634f;
constexpr int NWAVES = 8;

constexpr size_t MiB = 1u << 20;
constexpr size_t WS_CTL = 0, CTL_ZERO_BYTES = 1 * MiB;
constexpr size_t WS_MOD = 1 * MiB;
constexpr size_t WS_LOGF = 1 * MiB + 256 * 1024;
constexpr size_t WS_F = 2 * MiB + 256 * 1024;
constexpr size_t WS_LIST = 4 * MiB;
constexpr size_t WS_LW = 6 * MiB;
constexpr size_t WS_WIN = 8 * MiB;
constexpr size_t WS_WBR = 18 * MiB;
constexpr size_t WS_WOUT = 20 * MiB;
constexpr size_t WS_WGU = 22 * MiB;
constexpr size_t WS_WD = 54 * MiB;
constexpr size_t WS_XN = 72 * MiB;
constexpr size_t WS_Q = 136 * MiB;
constexpr size_t WS_K = 200 * MiB;
constexpr size_t WS_V = 264 * MiB;
constexpr size_t WS_GA = 328 * MiB;
constexpr size_t WS_GB = 392 * MiB;
constexpr size_t WS_ACT = 136 * MiB;
constexpr size_t WS_Y = 328 * MiB;
constexpr size_t WS_END = 456 * MiB;
constexpr int CW_BAR = 4096;
constexpr int CW_CNT = 16384;
constexpr int CW_KMAX = 20480;

constexpr int RING_BYTES = 131072;
constexpr int MISC_OFF = RING_BYTES;
constexpr int TAB_OFF = RING_BYTES + 1024;
constexpr int LDS_BYTES = 147456;

__device__ __forceinline__ unsigned f2bf(float f) { unsigned u = __builtin_bit_cast(unsigned, f); return (u + 0x7fffu + ((u >> 16) & 1u)) >> 16; }
__device__ __forceinline__ unsigned pk2(float lo, float hi) { return f2bf(lo) | (f2bf(hi) << 16); }
__device__ __forceinline__ float bflo(unsigned w) { return __builtin_bit_cast(float, w << 16); }
__device__ __forceinline__ float bfhi(unsigned w) { return __builtin_bit_cast(float, w & 0xffff0000u); }
#define LDS_WAIT() asm volatile("s_waitcnt lgkmcnt(0)" ::: "memory")
#define VM_WAIT() asm volatile("s_waitcnt vmcnt(0)" ::: "memory")

namespace pg8 {
#define PG8_LAS __attribute__((address_space(3)))
typedef unsigned short bf16_t;
typedef unsigned u32x4 __attribute__((ext_vector_type(4)));
constexpr int BM = 256, BK = 64, HALF = 128, HTB = HALF * BK * 2, STAGE_BYTES = 8 * HTB, NXCD = 8, WGM = 8;

__host__ __device__ __forceinline__ int lds_byte(int r, int c) { const int st = (r >> 4) * 2 + (c >> 5), rr = r & 15, cc = c & 31, ob = rr * 64 + cc * 2; return st * 1024 + (ob ^ (((ob >> 9) & 1) << 5)); }
__host__ __device__ __forceinline__ void stage_rc(int b, int& R, int& C) { const int st = b / 1024, sb = b % 1024, swz = sb ^ (((sb >> 9) & 1) << 5); R = (st >> 1) * 16 + swz / 64; C = (st & 1) * 32 + (swz % 64) / 2; }
__host__ __device__ __forceinline__ int perm32(int rho) { const int n = rho >> 4, i = rho & 15; return 8 * (i >> 2) + 4 * n + (i & 3); }

struct Unit { int pm, pn, e, row0; };
struct Gemm { const bf16_t* A; const bf16_t* Bt; int K, lda, ldb; };

struct StaticOrder {
    int nM, nN, nwg, G, c;
    __device__ void init(int M, int N, int G_, int c_) { nM = M / BM; nN = N / BM; nwg = nM * nN; G = G_; c = c_; }
    __device__ __forceinline__ bool next(int i, Unit& u) const {
        const long L = (long)i * G + c; if (L >= nwg) return false;
        int wgid = (int)L; { const int q = nwg / NXCD, r = nwg % NXCD, xcd = wgid % NXCD, off = wgid / NXCD; wgid = (xcd < r ? xcd * (q + 1) : r * (q + 1) + (xcd - r) * q) + off; }
        const int nig = WGM * nN, gid = wgid / nig, fm = gid * WGM, gsz = (nM - fm) < WGM ? (nM - fm) : WGM;
        u.pm = fm + ((wgid % nig) % gsz); u.pn = (wgid % nig) / gsz; u.e = 0; u.row0 = 0; return true;
    }
    __device__ __forceinline__ const char* abase(const Gemm& g, const Unit& u) const { return (const char*)g.A + (size_t)u.pm * BM * g.lda * 2; }
    __device__ __forceinline__ const char* bbase(const Gemm& g, const Unit& u) const { return (const char*)g.Bt + (size_t)u.pn * BM * g.ldb * 2; }
};
struct MoeOrder {
    const PG8_LAS int* tab; int G, c; size_t estride; bool gatherA;
    __device__ __forceinline__ bool next(int i, Unit& u) const {
        const int ln = (int)(threadIdx.x & 63); const int tv = tab[ln & 31];
        const int RT = __builtin_amdgcn_readlane(tv, 16); const int L = i * G + c; if (L >= RT * 4) return false;
        const int rt = L >> 2;
        const int e = __builtin_popcountll(__ballot(ln >= 1 && ln < 16 && rt >= tv));
        const int tpe = __builtin_amdgcn_readfirstlane(tab[e]);
        u.pm = rt; u.pn = L & 3; u.e = e; u.row0 = (rt - tpe) * BM; return true;
    }
    __device__ __forceinline__ const char* abase(const Gemm& g, const Unit& u) const { return gatherA ? (const char*)g.A : (const char*)g.A + (size_t)u.pm * BM * g.lda * 2; }
    __device__ __forceinline__ const char* bbase(const Gemm& g, const Unit& u) const { return (const char*)g.Bt + (size_t)u.e * estride + (size_t)u.pn * BM * g.ldb * 2; }
};

__device__ __forceinline__ unsigned cvt_pk_bf16(float lo, float hi) { unsigned r; asm volatile("v_cvt_pk_bf16_f32 %0, %1, %2" : "=v"(r) : "v"(lo), "v"(hi)); return r; }

struct EpiSplit {
    static constexpr bool PERM = true, HAS_MID = false;
    bf16_t* O; int ldc; int split_cols; size_t split_stride; float scale0; unsigned* kmax;
    __device__ __forceinline__ void operator()(const f32x4 (&acc)[2][2][4][2], const Unit& u, int wr, int wc, int fr, int fq) const {
        const int row0 = u.pm * BM + wr * 64 + fr; int colt = u.pn * BM; bf16_t* base = O;
        float sc = 1.f; const int tsplit = colt / split_cols; { const int t = tsplit; base += (size_t)t * split_stride; colt -= t * split_cols; if (t == 0) sc = scale0; }
        if (tsplit == 1 && colt < 512) {
#pragma unroll
            for (int bj = 0; bj < 2; ++bj) { float mxv = 0.f;
#pragma unroll
                for (int ai = 0; ai < 2; ++ai)
#pragma unroll
                    for (int m = 0; m < 4; ++m) { const f32x4 a = acc[ai][bj][m][0], c = acc[ai][bj][m][1];
                        float q = (a[0] * a[0] + a[1] * a[1]) + (a[2] * a[2] + a[3] * a[3]) + (c[0] * c[0] + c[1] * c[1]) + (c[2] * c[2] + c[3] * c[3]);
                        q += __shfl_xor(q, 16); q += __shfl_xor(q, 32); mxv = fmaxf(mxv, q); }
                mxv = fmaxf(mxv, __shfl_xor(mxv, 1)); mxv = fmaxf(mxv, __shfl_xor(mxv, 2)); mxv = fmaxf(mxv, __shfl_xor(mxv, 4)); mxv = fmaxf(mxv, __shfl_xor(mxv, 8));
                if (fr == 0 && fq == 0) { const int head = (colt >> 6) + 2 * bj + (wc >> 1), b = (u.pm * BM) / SEQ;
                    __hip_atomic_fetch_max(kmax + ((b * 8 + head) * 2 + (wc & 1)), __builtin_bit_cast(unsigned, mxv), __ATOMIC_RELAXED, __HIP_MEMORY_SCOPE_AGENT); } }
        }
        const int col0 = colt + wc * 32 + 8 * fq;
#pragma unroll
        for (int ai = 0; ai < 2; ++ai)
#pragma unroll
            for (int m = 0; m < 4; ++m) { bf16_t* rowp = base + (size_t)(row0 + ai * HALF + m * 16) * ldc + col0;
#pragma unroll
                for (int bj = 0; bj < 2; ++bj) { f32x4 v0 = acc[ai][bj][m][0] * sc, v1 = acc[ai][bj][m][1] * sc;
                    u32x4 w; w.x = cvt_pk_bf16(v0[0], v0[1]); w.y = cvt_pk_bf16(v0[2], v0[3]); w.z = cvt_pk_bf16(v1[0], v1[1]); w.w = cvt_pk_bf16(v1[2], v1[3]);
                    *(u32x4*)(rowp + bj * HALF) = w; } }
    }
    __device__ __forceinline__ void mid(f32x4 (&)[2][2][4][2], const Unit&, int, int, int, int) const {}
};
struct EpiMerge {
    static constexpr bool PERM = true, HAS_MID = true;
    const bf16_t* GA; const bf16_t* GB; bf16_t* O;
    __device__ __forceinline__ void mid(f32x4 (&acc)[2][2][4][2], const Unit& u, int wr, int wc, int fr, int fq) const {
        const int row0 = u.pm * BM + wr * 64 + fr, col0 = u.pn * BM + wc * 32 + 8 * fq;
#pragma unroll
        for (int ai = 0; ai < 2; ++ai)
#pragma unroll
            for (int m = 0; m < 4; ++m) { const size_t ro = (size_t)(row0 + ai * HALF + m * 16) * D + col0;
#pragma unroll
                for (int bj = 0; bj < 2; ++bj) { const u32x4 a = *(const u32x4*)(GA + ro + bj * HALF), b = *(const u32x4*)(GB + ro + bj * HALF);
                    float r[8];
#pragma unroll
                    for (int j = 0; j < 4; ++j) { const float a0 = bflo(a[j]), a1 = bfhi(a[j]), b0 = bflo(b[j]), b1 = bfhi(b[j]);
                        r[2 * j] = (1.f + __expf(-b0)) / (1.f + __expf(-a0)); r[2 * j + 1] = (1.f + __expf(-b1)) / (1.f + __expf(-a1)); }
                    acc[ai][bj][m][0] = acc[ai][bj][m][0] * (f32x4){r[0], r[1], r[2], r[3]}; acc[ai][bj][m][1] = acc[ai][bj][m][1] * (f32x4){r[4], r[5], r[6], r[7]}; } }
    }
    __device__ __forceinline__ void operator()(const f32x4 (&acc)[2][2][4][2], const Unit& u, int wr, int wc, int fr, int fq) const {
        const int row0 = u.pm * BM + wr * 64 + fr, col0 = u.pn * BM + wc * 32 + 8 * fq;
#pragma unroll
        for (int ai = 0; ai < 2; ++ai)
#pragma unroll
            for (int m = 0; m < 4; ++m) { const size_t ro = (size_t)(row0 + ai * HALF + m * 16) * D + col0;
#pragma unroll
                for (int bj = 0; bj < 2; ++bj) { const u32x4 b = *(const u32x4*)(GB + ro + bj * HALF);
                    float s[8];
#pragma unroll
                    for (int j = 0; j < 4; ++j) { s[2 * j] = 1.f / (1.f + __expf(-bflo(b[j]))); s[2 * j + 1] = 1.f / (1.f + __expf(-bfhi(b[j]))); }
                    const f32x4 v0 = acc[ai][bj][m][0] * (f32x4){s[0], s[1], s[2], s[3]}, v1 = acc[ai][bj][m][1] * (f32x4){s[4], s[5], s[6], s[7]};
                    u32x4 w; w.x = cvt_pk_bf16(v0[0], v0[1]); w.y = cvt_pk_bf16(v0[2], v0[3]); w.z = cvt_pk_bf16(v1[0], v1[1]); w.w = cvt_pk_bf16(v1[2], v1[3]);
                    *(u32x4*)(O + ro + bj * HALF) = w; } }
    }
};
struct EpiResid {
    static constexpr bool PERM = false, HAS_MID = false;
    const float* X; const float* gate; float* O;
    __device__ __forceinline__ void operator()(const f32x4 (&acc)[2][2][4][2], const Unit& u, int wr, int wc, int fr, int fq) const {
        const int row0 = u.pm * BM + wr * 64 + fr, col0 = u.pn * BM + wc * 32 + 4 * fq; const int b = (u.pm * BM) / SEQ;
        f32x4 gv[2][2];
#pragma unroll
        for (int bj = 0; bj < 2; ++bj)
#pragma unroll
            for (int n = 0; n < 2; ++n) gv[bj][n] = *(const f32x4*)(gate + (size_t)b * NMOD * D + col0 + bj * HALF + n * 16);
#pragma unroll
        for (int ai = 0; ai < 2; ++ai)
#pragma unroll
            for (int m = 0; m < 4; ++m) { const size_t ro = (size_t)(row0 + ai * HALF + m * 16) * D + col0;
#pragma unroll
                for (int bj = 0; bj < 2; ++bj)
#pragma unroll
                    for (int n = 0; n < 2; ++n) { const f32x4 xv = *(const f32x4*)(X + ro + bj * HALF + n * 16);
                        *(f32x4*)(O + ro + bj * HALF + n * 16) = xv + gv[bj][n] * acc[ai][bj][m][n]; } }
    }
    __device__ __forceinline__ void mid(f32x4 (&)[2][2][4][2], const Unit&, int, int, int, int) const {}
};
struct EpiAct {
    static constexpr bool PERM = true, HAS_MID = false;
    bf16_t* ACT;
    __device__ __forceinline__ void operator()(const f32x4 (&acc)[2][2][4][2], const Unit& u, int wr, int wc, int fr, int fq) const {
        const int row0 = u.pm * BM + wr * 64 + fr, col0 = u.pn * 128 + wc * 32 + 8 * fq;
#pragma unroll
        for (int ai = 0; ai < 2; ++ai)
#pragma unroll
            for (int m = 0; m < 4; ++m) { float a[8];
#pragma unroll
                for (int n = 0; n < 2; ++n)
#pragma unroll
                    for (int j = 0; j < 4; ++j) { const float gg = acc[ai][0][m][n][j], uu = acc[ai][1][m][n][j]; a[4 * n + j] = gg / (1.f + __expf(-gg)) * uu; }
                u32x4 w; w.x = cvt_pk_bf16(a[0], a[1]); w.y = cvt_pk_bf16(a[2], a[3]); w.z = cvt_pk_bf16(a[4], a[5]); w.w = cvt_pk_bf16(a[6], a[7]);
                *(u32x4*)(ACT + (size_t)(row0 + ai * HALF + m * 16) * DFF + col0) = w; }
    }
    __device__ __forceinline__ void mid(f32x4 (&)[2][2][4][2], const Unit&, int, int, int, int) const {}
};
struct EpiDown {
    static constexpr bool PERM = true, HAS_MID = false;
    const int* list; const float* lw; const PG8_LAS int* tab; bf16_t* Y;
    __device__ __forceinline__ void operator()(const f32x4 (&acc)[2][2][4][2], const Unit& u, int wr, int wc, int fr, int fq) const {
        const int cnt = __builtin_amdgcn_readfirstlane(tab[32 + u.e]), col0 = u.pn * BM + wc * 32 + 8 * fq;
#pragma unroll
        for (int ai = 0; ai < 2; ++ai)
#pragma unroll
            for (int m = 0; m < 4; ++m) { const int pos = u.row0 + ai * HALF + wr * 64 + m * 16 + fr;
                if (pos < cnt) { const int ent = list[u.e * NTOK + pos]; const float w = lw[u.e * NTOK + pos];
                    bf16_t* dst = Y + ((size_t)(ent & 1) * NTOK + (size_t)(ent >> 1)) * D + col0;
#pragma unroll
                    for (int bj = 0; bj < 2; ++bj) { const f32x4 v0 = acc[ai][bj][m][0] * w, v1 = acc[ai][bj][m][1] * w;
                        u32x4 o; o.x = cvt_pk_bf16(v0[0], v0[1]); o.y = cvt_pk_bf16(v0[2], v0[3]); o.z = cvt_pk_bf16(v1[0], v1[1]); o.w = cvt_pk_bf16(v1[2], v1[3]);
                        *(u32x4*)(dst + bj * HALF) = o; } } }
    }
    __device__ __forceinline__ void mid(f32x4 (&)[2][2][4][2], const Unit&, int, int, int, int) const {}
};

template <class Epi, class Sched, bool ALIGN_EPI, bool GATHER>
__device__ __forceinline__ void gemm_phase(PG8_LAS unsigned char* lds, const Gemm g, const Sched& S, const Epi& E, const PG8_LAS int* gtab) {
    const int tid = threadIdx.x, wid = __builtin_amdgcn_readfirstlane(tid >> 6), lane = tid & 63, wr = wid >> 2, wc = wid & 3, fr = lane & 15, fq = lane >> 4;
    const int K = g.K, nt = K / BK;
    unsigned vA[2][2], voffB[2];
#pragma unroll
    for (int i = 0; i < 2; ++i) { int R, C; stage_rc(tid * 16 + i * 8192, R, C); const int Rb = Epi::PERM ? ((R & ~31) + perm32(R & 31)) : R;
        voffB[i] = (unsigned)(Rb * g.ldb + C) * 2u; vA[0][i] = (unsigned)(R * g.lda + C) * 2u; vA[1][i] = (unsigned)((R + HALF) * g.lda + C) * 2u; }
    const size_t kstep = (size_t)(BK * 2);
    const size_t hstepB = (size_t)HALF * g.ldb * 2;
    const unsigned ldsw = (unsigned)wid * 1024u;
    const int aoff = lds_byte(wr * 64 + fr, fq * 8), boff = lds_byte(wc * 32 + fr, fq * 8);
#define PG8_SA(b, h) (((b) * 2 + (h)) * HTB)
#define PG8_SB(b, h) ((4 + (b) * 2 + (h)) * HTB)
#define PG8_STAGE2(bufoff, gbase, o0, o1) do { \
        __builtin_amdgcn_global_load_lds((const unsigned*)((const char*)(gbase) + (o0)), (PG8_LAS unsigned*)(lds + (bufoff) + ldsw), 16, 0, 0); \
        __builtin_amdgcn_global_load_lds((const unsigned*)((const char*)(gbase) + (o1)), (PG8_LAS unsigned*)(lds + (bufoff) + ldsw + 8192), 16, 0, 0); } while (0)
#define PG8_STAGE_B(bufoff, gbase) PG8_STAGE2(bufoff, gbase, voffB[0], voffB[1])
#define PG8_STAGE_A(bufoff, gbase, h) PG8_STAGE2(bufoff, gbase, vA[h][0], vA[h][1])
#define PG8_STAGE_AX(bufoff, gbase, h) PG8_STAGE2(bufoff, gbase, xA[h][0], xA[h][1])
#define PG8_LDA(dst, b, h) do { _Pragma("unroll") for (int m = 0; m < 4; ++m) _Pragma("unroll") for (int k = 0; k < 2; ++k) dst[m][k] = *(const PG8_LAS bf16x8*)(lds + PG8_SA(b, h) + aoff + m * 2048 + k * 1024); } while (0)
#define PG8_LDB(dst, b, h) do { _Pragma("unroll") for (int n = 0; n < 2; ++n) _Pragma("unroll") for (int k = 0; k < 2; ++k) dst[n][k] = *(const PG8_LAS bf16x8*)(lds + PG8_SB(b, h) + boff + n * 2048 + k * 1024); } while (0)
#define PG8_MMA(ai, bj, At, Bt) do { __builtin_amdgcn_s_setprio(1); _Pragma("unroll") for (int m = 0; m < 4; ++m) _Pragma("unroll") for (int n = 0; n < 2; ++n) _Pragma("unroll") for (int k = 0; k < 2; ++k) \
        acc[ai][bj][m][n] = __builtin_amdgcn_mfma_f32_16x16x32_bf16(Bt[n][k], At[m][k], acc[ai][bj][m][n], 0, 0, 0); __builtin_amdgcn_s_setprio(0); } while (0)
#define PG8_WAIT_V(n) asm volatile("s_waitcnt vmcnt(" #n ")" ::: "memory")
#define PG8_WAIT_L(n) asm volatile("s_waitcnt lgkmcnt(" #n ")" ::: "memory")
#define PG8_BAR __builtin_amdgcn_s_barrier()
#define PG8_SCHED __builtin_amdgcn_sched_barrier(0)
    Unit cur, nxt; int ui = 0;
    if (!S.next(0, cur)) return;
    if constexpr (GATHER) {
#pragma unroll
        for (int h = 0; h < 2; ++h)
#pragma unroll
            for (int i = 0; i < 2; ++i) { int R, C; stage_rc(tid * 16 + i * 8192, R, C); vA[h][i] = (unsigned)gtab[R + h * HALF] * (unsigned)(g.lda * 2) + (unsigned)C * 2u; }
    }
    f32x4 acc[2][2][4][2];
#pragma unroll
    for (int a = 0; a < 2; ++a)
#pragma unroll
        for (int b = 0; b < 2; ++b)
#pragma unroll
            for (int m = 0; m < 4; ++m)
#pragma unroll
                for (int n = 0; n < 2; ++n) acc[a][b][m][n] = (f32x4){0.f, 0.f, 0.f, 0.f};
    bf16x8 At[4][2], B0[2][2], B1[2][2];
    const char* cA = S.abase(g, cur); const char* cB = S.bbase(g, cur);
    PG8_STAGE_B(PG8_SB(0, 0), cB); PG8_STAGE_B(PG8_SB(0, 1), cB + hstepB); PG8_STAGE_A(PG8_SA(0, 0), cA, 0); PG8_STAGE_A(PG8_SA(0, 1), cA, 1);
    if (wr == 1) PG8_BAR;
    PG8_WAIT_V(2); PG8_BAR;
    PG8_STAGE_B(PG8_SB(1, 0), cB + kstep); PG8_STAGE_A(PG8_SA(1, 0), cA + kstep, 0); PG8_STAGE_B(PG8_SB(1, 1), cB + hstepB + kstep);
    PG8_WAIT_V(6); PG8_BAR;
    for (;;) {
        const bool has_next = S.next(ui + 1, nxt);
        const char* nA = has_next ? S.abase(g, nxt) : cA; const char* nB = has_next ? S.bbase(g, nxt) : cB;
        for (int t = 0; t < nt; t += 2) {
            const bool last = (t == nt - 2);
            if constexpr (Epi::HAS_MID) { if (t == (nt >> 1)) { int fr_e = fr, fq_e = fq; asm volatile("" : "+v"(fr_e), "+v"(fq_e)); E.mid(acc, cur, wr, wc, fr_e, fq_e); } }
            const char* a1 = cA + (size_t)(t + 1) * kstep;
            const char* a2 = last ? nA : cA + (size_t)(t + 2) * kstep; const char* b2 = last ? nB : cB + (size_t)(t + 2) * kstep;
            const char* a3 = a2 + kstep; const char* b3 = b2 + kstep;
            unsigned xA[2][2];
#pragma unroll
            for (int h = 0; h < 2; ++h)
#pragma unroll
                for (int i = 0; i < 2; ++i) xA[h][i] = vA[h][i];
            if constexpr (GATHER) { if (last && has_next) {
#pragma unroll
                for (int h = 0; h < 2; ++h)
#pragma unroll
                    for (int i = 0; i < 2; ++i) { int R, C; stage_rc(tid * 16 + i * 8192, R, C); xA[h][i] = (unsigned)gtab[(ui + 1) * BM + R + h * HALF] * (unsigned)(g.lda * 2) + (unsigned)C * 2u; } } }
            PG8_LDB(B0, 0, 0); PG8_LDB(B1, 0, 1); PG8_SCHED; PG8_LDA(At, 0, 0); PG8_STAGE_A(PG8_SA(1, 1), a1, 1);
            PG8_WAIT_V(8); PG8_WAIT_L(0); PG8_BAR; PG8_MMA(0, 0, At, B0); PG8_MMA(0, 1, At, B1); PG8_BAR; PG8_SCHED;
            PG8_LDA(At, 0, 1); PG8_STAGE_B(PG8_SB(0, 0), b2); PG8_STAGE_B(PG8_SB(0, 1), b2 + hstepB); PG8_STAGE_AX(PG8_SA(0, 0), a2, 0);
            PG8_WAIT_V(8); PG8_WAIT_L(0); PG8_BAR; PG8_MMA(1, 0, At, B0); PG8_MMA(1, 1, At, B1); PG8_BAR; PG8_SCHED;
            PG8_LDB(B0, 1, 0); PG8_LDB(B1, 1, 1); PG8_SCHED; PG8_LDA(At, 1, 0); PG8_STAGE_AX(PG8_SA(0, 1), a2, 1);
            PG8_WAIT_V(8); PG8_WAIT_L(0); PG8_BAR; PG8_MMA(0, 0, At, B0); PG8_MMA(0, 1, At, B1); PG8_BAR; PG8_SCHED;
            PG8_LDA(At, 1, 1); PG8_STAGE_B(PG8_SB(1, 0), b3); PG8_STAGE_B(PG8_SB(1, 1), b3 + hstepB); PG8_STAGE_AX(PG8_SA(1, 0), a3, 0);
            PG8_WAIT_V(8); PG8_WAIT_L(0); PG8_BAR; PG8_MMA(1, 0, At, B0); PG8_MMA(1, 1, At, B1); PG8_BAR; PG8_SCHED;
        }
        if constexpr (ALIGN_EPI) { if (wr == 0) PG8_BAR; }
        { int fr_e = fr, fq_e = fq; asm volatile("" : "+v"(fr_e), "+v"(fq_e)); E(acc, cur, wr, wc, fr_e, fq_e); }
        if (!has_next) break;
#pragma unroll
        for (int a = 0; a < 2; ++a)
#pragma unroll
            for (int b = 0; b < 2; ++b)
#pragma unroll
                for (int m = 0; m < 4; ++m)
#pragma unroll
                    for (int n = 0; n < 2; ++n) acc[a][b][m][n] = (f32x4){0.f, 0.f, 0.f, 0.f};
        cur = nxt; cA = nA; cB = nB; ++ui;
        if constexpr (GATHER) {
#pragma unroll
            for (int h = 0; h < 2; ++h)
#pragma unroll
                for (int i = 0; i < 2; ++i) { int R, C; stage_rc(tid * 16 + i * 8192, R, C); vA[h][i] = (unsigned)gtab[ui * BM + R + h * HALF] * (unsigned)(g.lda * 2) + (unsigned)C * 2u; }
        }
        if constexpr (ALIGN_EPI) { if (wr == 1) PG8_BAR; }
    }
    PG8_WAIT_V(0);
    if constexpr (!ALIGN_EPI) { if (wr == 0) PG8_BAR; }
    PG8_BAR;
#undef PG8_SA
#undef PG8_SB
#undef PG8_STAGE2
#undef PG8_STAGE_A
#undef PG8_STAGE_AX
#undef PG8_STAGE_B
#undef PG8_LDA
#undef PG8_LDB
#undef PG8_MMA
#undef PG8_WAIT_V
#undef PG8_WAIT_L
#undef PG8_BAR
#undef PG8_SCHED
}
}

#define XB_TMO      128
#define XB_XCNT(j)  (256  + 64 * (j))
#define XB_XSUB(j)  (1280 + 64 * (j))
#define XB_XGEN(j)  (2304 + 64 * (j))
#define XB_TOP      3328
#define XB_TOPGEN   3392
#define XCD_BAR_WORDS 3456
#define XB_SPIN_CAP (1u << 18)

__device__ __forceinline__ unsigned xb_ld(unsigned* p)              { return __hip_atomic_load(p, __ATOMIC_RELAXED, __HIP_MEMORY_SCOPE_AGENT); }
__device__ __forceinline__ unsigned xb_add(unsigned* p, unsigned v) { return __hip_atomic_fetch_add(p, v, __ATOMIC_RELAXED, __HIP_MEMORY_SCOPE_AGENT); }
__device__ __forceinline__ unsigned xb_xcc_id() { return (unsigned)__builtin_amdgcn_s_getreg((3 << 11) | 20) & 0xFu; }
#define XB_SPIN(cond, bar) do { unsigned _sp = 0; while (cond) { __builtin_amdgcn_s_sleep(1); \
    if ((++_sp & 255u) == 0u) { if (xb_ld(&(bar)[XB_TMO])) break; if (_sp > XB_SPIN_CAP) { atomicAdd(&(bar)[XB_TMO], 1u); break; } } } } while (0)

struct XcdBarrier { unsigned* bar; unsigned x; volatile LAS unsigned* st; };

__device__ __forceinline__ XcdBarrier xcd_barrier_post(unsigned* bar, volatile LAS unsigned* st) {
    XcdBarrier b; b.bar = bar; b.x = xb_xcc_id(); b.st = st;
    if (threadIdx.x == 0) (void)xb_add(&bar[XB_XCNT(b.x)], 1u);
    return b;
}
__device__ __forceinline__ void xcd_barrier_complete(unsigned* bar, unsigned x, unsigned& nloc, unsigned& nx) {
    const unsigned G = gridDim.x * gridDim.y * gridDim.z;
    unsigned sum, cnt, mine, sp = 0u;
    for (;;) {
        sum = 0u; cnt = 0u; mine = 0u;
#pragma unroll
        for (unsigned j = 0; j < 16; ++j) { const unsigned c = xb_ld(&bar[XB_XCNT(j)]); sum += c; cnt += (c > 0u) ? 1u : 0u; mine = (j == x) ? c : mine; }
        if (sum == G) break;
        __builtin_amdgcn_s_sleep(1);
        if ((++sp & 255u) == 0u) { if (xb_ld(&bar[XB_TMO])) break; if (sp > XB_SPIN_CAP) { atomicAdd(&bar[XB_TMO], 1u); break; } }
    }
    nloc = mine > 0u ? mine : 1u; nx = cnt > 0u ? cnt : 1u;
}
__device__ __forceinline__ void xcd_barrier(const XcdBarrier& b) {
    asm volatile("s_waitcnt vmcnt(0)" ::: "memory");
    __syncthreads();
    if (threadIdx.x == 0) {
        unsigned* bar = b.bar;
        __builtin_amdgcn_s_waitcnt(0);
        unsigned nloc = b.st[0], nx = b.st[1];
        if (nloc == 0u) { xcd_barrier_complete(bar, b.x, nloc, nx); b.st[0] = nloc; b.st[1] = nx; }
        const unsigned old = xb_add(&bar[XB_XSUB(b.x)], 1u);
        const unsigned gen = old / nloc;
        if (old + 1u == (gen + 1u) * nloc) {
            __builtin_amdgcn_fence(__ATOMIC_RELEASE, "agent");
            asm volatile("s_waitcnt vmcnt(0)" ::: "memory");
            const unsigned og = xb_add(&bar[XB_TOP], 1u);
            const unsigned tg = og / nx;
            if (og + 1u == (tg + 1u) * nx) xb_add(&bar[XB_TOPGEN], 1u);
            else XB_SPIN(xb_ld(&bar[XB_TOPGEN]) == tg, bar);
            __builtin_amdgcn_fence(__ATOMIC_ACQUIRE, "agent");
            xb_add(&bar[XB_XGEN(b.x)], 1u);
            asm volatile("s_waitcnt vmcnt(0)" ::: "memory");
        } else {
            XB_SPIN(xb_ld(&bar[XB_XGEN(b.x)]) == gen, bar);
            __builtin_amdgcn_fence(__ATOMIC_ACQUIRE, "agent");
            asm volatile("s_waitcnt vmcnt(0)" ::: "memory");
        }
    }
    __syncthreads();
}


namespace att {
typedef float f32x16 __attribute__((ext_vector_type(16)));
typedef short v4i16_t __attribute__((ext_vector_type(4)));
constexpr float ATT_THR = 40.f;
__device__ __forceinline__ int crow(int r, int hi) { return (r & 3) + 8 * (r >> 2) + 4 * hi; }
__device__ __forceinline__ unsigned cvtpk(float lo, float hi) { typedef float f2 __attribute__((ext_vector_type(2))); typedef __bf16 b2 __attribute__((ext_vector_type(2))); f2 v = {lo, hi}; b2 b = __builtin_convertvector(v, b2); return __builtin_bit_cast(unsigned, b); }
__device__ __forceinline__ bf16x8 pack8(const f32x16& p, int b0) { v4u w; w.x = cvtpk(p[b0], p[b0 + 1]); w.y = cvtpk(p[b0 + 2], p[b0 + 3]); w.z = cvtpk(p[b0 + 4], p[b0 + 5]); w.w = cvtpk(p[b0 + 6], p[b0 + 7]); return __builtin_bit_cast(bf16x8, w); }

template <bool SB>
__device__ __forceinline__ void attn_wave(int b, int hc, int q0, const bf16* Q, const bf16* K, const bf16* V, bf16* O, const float* Frow, float bk2, LAS unsigned char* vlds, int lane) {
    const int r32 = lane & 31, hi = lane >> 5;
    const size_t rowb = (size_t)b * SEQ;
    const bf16* Kh = K + rowb * D + hc; const bf16* Vh = V + rowb * D + hc;
    bf16x8 qr[4];
#pragma unroll
    for (int d0 = 0; d0 < 4; ++d0) qr[d0] = *(const bf16x8*)(Q + (rowb + q0 + r32) * D + hc + 16 * d0 + 8 * hi);
    const bf16* ksrc = Kh + (size_t)r32 * D + 8 * hi;
    const bf16* vsrc = Vh + (size_t)(lane >> 2) * D + (lane & 3) * 8;
    LAS unsigned char* vw = vlds + lane * 16;
    LAS unsigned char* vrd = vlds + ((lane >> 4) & 1) * 32 + (lane & 3) * 8 + (4 * hi + ((lane & 15) >> 2)) * 64;
    const int td = q0 >> 6, qabs = q0 + r32;
    bf16x8 kf[8]; v4u vst[8];
#define ATT_LOADK(t_) do { _Pragma("unroll") for (int d0 = 0; d0 < 4; ++d0) { kf[2 * d0] = *(const bf16x8*)(ksrc + (size_t)((t_) * 64) * D + 16 * d0); kf[2 * d0 + 1] = *(const bf16x8*)(ksrc + (size_t)((t_) * 64 + 32) * D + 16 * d0); } } while (0)
#define ATT_LOADV(t_) do { _Pragma("unroll") for (int p = 0; p < 8; ++p) vst[p] = *(const v4u*)(vsrc + (size_t)((t_) * 64 + 16 * (p & 3)) * D + 32 * (p >> 2)); } while (0)
#define ATT_WRITEV(sl_) do { _Pragma("unroll") for (int p = 0; p < 8; ++p) *(LAS v4u*)(vw + (sl_) * 8192 + p * 1024) = vst[p]; } while (0)
    int t = td, slot = 0;
    ATT_LOADK(t); ATT_LOADV(t); ATT_WRITEV(0);
    f32x16 o[2];
#pragma unroll
    for (int r = 0; r < 16; ++r) { o[0][r] = 0.f; o[1][r] = 0.f; }
    float m = -INFINITY, l = 0.f, FrL = 0.f, bqbk = 0.f;
    float carry = 0.f; bf16x8 T0, T1;
    if constexpr (SB) {
        v4u a, c;
#pragma unroll
        for (int w = 0; w < 4; ++w) { unsigned lo, hi2;
            { const int jj = 2 * w; const int j0 = 8 * (jj >> 2) + 4 * hi + (jj & 3), j1 = j0 + 1;
              lo = ((j0 > r32) ? 0x3F80u : 0u) | ((j1 > r32) ? 0x3F800000u : 0u); hi2 = ((16 + j0 > r32) ? 0x3F80u : 0u) | ((16 + j1 > r32) ? 0x3F800000u : 0u); }
            a[w] = lo; c[w] = hi2; }
        T0 = __builtin_bit_cast(bf16x8, a); T1 = __builtin_bit_cast(bf16x8, c);
    } else {
        FrL = Frow[q0] * LOG2E;
        float qs = 0.f;
#pragma unroll
        for (int d0 = 0; d0 < 4; ++d0) { const v4u w = __builtin_bit_cast(v4u, qr[d0]);
#pragma unroll
            for (int e = 0; e < 4; ++e) { const float x0 = bflo(w[e]), x1 = bfhi(w[e]); qs += x0 * x0 + x1 * x1; } }
        qs += __shfl_xor(qs, 32);
#pragma unroll
        for (int off = 1; off < 32; off <<= 1) qs = fmaxf(qs, __shfl_xor(qs, off));
        bqbk = sqrtf(qs * bk2) * 1.02f + 0.01f;
    }
    for (;;) {
        const int kv0 = t * 64; const bool more = t > 0, diag = (t == td);
        if (more) ATT_LOADV(t - 1);
        f32x16 p0, p1;
        if constexpr (SB) {
#pragma unroll
            for (int r = 0; r < 16; ++r) { p0[r] = 0.f; p1[r] = 0.f; }
        } else {
#pragma unroll
            for (int g = 0; g < 4; ++g) { const f32x4 fa = *(const f32x4*)(Frow + kv0 + 8 * g + 4 * hi), fb = *(const f32x4*)(Frow + kv0 + 32 + 8 * g + 4 * hi);
#pragma unroll
                for (int c = 0; c < 4; ++c) { p0[4 * g + c] = __builtin_fmaf(fa[c], -LOG2E, FrL); p1[4 * g + c] = __builtin_fmaf(fb[c], -LOG2E, FrL); } }
        }
#pragma unroll
        for (int d0 = 0; d0 < 4; ++d0) { p0 = __builtin_amdgcn_mfma_f32_32x32x16_bf16(kf[2 * d0], qr[d0], p0, 0, 0, 0); p1 = __builtin_amdgcn_mfma_f32_32x32x16_bf16(kf[2 * d0 + 1], qr[d0], p1, 0, 0, 0); }
        if (more) ATT_LOADK(t - 1);
        bf16x8 pw[4];
        if constexpr (SB) {
            f32x16 lb0, lb1;
            float rt0 = 0.f, rt1 = 0.f;
#pragma unroll
            for (int r = 0; r < 16; ++r) {
                { const float z = p0[r], lg = __builtin_amdgcn_logf(1.f + __builtin_amdgcn_exp2f(-fabsf(z))); const float lbv = fminf(z, 0.f) - lg; float lm = lbv - z;
                  const bool valid = !diag || (kv0 + crow(r, hi) < qabs); lm = valid ? lm : 0.f; lb0[r] = valid ? lbv : -INFINITY; p0[r] = lm; rt0 += lm; }
                { const float z = p1[r], lg = __builtin_amdgcn_logf(1.f + __builtin_amdgcn_exp2f(-fabsf(z))); const float lbv = fminf(z, 0.f) - lg; float lm = lbv - z;
                  const bool valid = !diag || (kv0 + 32 + crow(r, hi) < qabs); lm = valid ? lm : 0.f; lb1[r] = valid ? lbv : -INFINITY; p1[r] = lm; rt1 += lm; }
            }
            rt0 += __shfl_xor(rt0, 32); rt1 += __shfl_xor(rt1, 32);
            const bf16x8 m0 = pack8(p0, 0), m1 = pack8(p0, 8), m2 = pack8(p1, 0), m3 = pack8(p1, 8);
            f32x16 s0, s1;
#pragma unroll
            for (int r = 0; r < 16; ++r) { s0[r] = carry + rt1; s1[r] = carry; }
            s0 = __builtin_amdgcn_mfma_f32_32x32x16_bf16(T0, m0, s0, 0, 0, 0); s0 = __builtin_amdgcn_mfma_f32_32x32x16_bf16(T1, m1, s0, 0, 0, 0);
            s1 = __builtin_amdgcn_mfma_f32_32x32x16_bf16(T0, m2, s1, 0, 0, 0); s1 = __builtin_amdgcn_mfma_f32_32x32x16_bf16(T1, m3, s1, 0, 0, 0);
#pragma unroll
            for (int r = 0; r < 16; ++r) { p0[r] = __builtin_amdgcn_exp2f(lb0[r] + s0[r]); p1[r] = __builtin_amdgcn_exp2f(lb1[r] + s1[r]); }
            carry += rt0 + rt1;
        } else {
            if (diag) {
#pragma unroll
                for (int r = 0; r < 16; ++r) { if (kv0 + crow(r, hi) > qabs) p0[r] = -INFINITY; if (kv0 + 32 + crow(r, hi) > qabs) p1[r] = -INFINITY; }
            }
            float mx = fmaxf(p0[0], p1[0]);
#pragma unroll
            for (int r = 1; r < 16; ++r) mx = fmaxf(mx, fmaxf(p0[r], p1[r]));
            mx = fmaxf(mx, __shfl_xor(mx, 32));
            const float mnew = fmaxf(m, mx);
            if (__any(mnew > m)) { const float sc = __builtin_amdgcn_exp2f(m - mnew); l *= sc;
#pragma unroll
                for (int r = 0; r < 16; ++r) { o[0][r] *= sc; o[1][r] *= sc; }
                m = mnew; }
            float ls = 0.f;
#pragma unroll
            for (int r = 0; r < 16; ++r) { p0[r] = __builtin_amdgcn_exp2f(p0[r] - m); p1[r] = __builtin_amdgcn_exp2f(p1[r] - m); ls += p0[r] + p1[r]; }
            l += ls;
        }
        pw[0] = pack8(p0, 0); pw[1] = pack8(p0, 8); pw[2] = pack8(p1, 0); pw[3] = pack8(p1, 8);
#pragma unroll
        for (int d0 = 0; d0 < 2; ++d0)
#pragma unroll
            for (int ks = 0; ks < 4; ++ks) {
                const v4i16_t lo = __builtin_amdgcn_ds_read_tr16_b64_v4i16((LAS v4i16_t*)(vrd + slot * 8192 + d0 * 4096 + ks * 1024));
                const v4i16_t hh = __builtin_amdgcn_ds_read_tr16_b64_v4i16((LAS v4i16_t*)(vrd + slot * 8192 + d0 * 4096 + ks * 1024 + 512));
                const bf16x8 vf = (bf16x8){lo[0], lo[1], lo[2], lo[3], hh[0], hh[1], hh[2], hh[3]};
                o[d0] = __builtin_amdgcn_mfma_f32_32x32x16_bf16(vf, pw[ks], o[d0], 0, 0, 0);
            }
        if (!more) break;
        if constexpr (SB) { if (__all(carry < -ATT_THR)) break; }
        else { const float ub = bqbk + __builtin_fmaf(Frow[kv0 - 1], -LOG2E, FrL); if (__all(ub < m - ATT_THR)) break; }
        ATT_WRITEV(slot ^ 1); slot ^= 1; --t;
    }
#undef ATT_LOADK
#undef ATT_LOADV
#undef ATT_WRITEV
    float inv = 1.f;
    if constexpr (!SB) { l += __shfl_xor(l, 32); inv = 1.f / l; }
    bf16* op = O + (rowb + q0 + r32) * D + hc + 4 * hi;
#pragma unroll
    for (int d0 = 0; d0 < 2; ++d0)
#pragma unroll
        for (int g = 0; g < 4; ++g) { v2u w; w.x = cvtpk(o[d0][4 * g] * inv, o[d0][4 * g + 1] * inv); w.y = cvtpk(o[d0][4 * g + 2] * inv, o[d0][4 * g + 3] * inv); *(v2u*)(op + 32 * d0 + 8 * g) = w; }
}
}

struct Frame {
    LAS unsigned char* lds;
    int tid, lane, wave, vcu, G;
};
__device__ __forceinline__ float wave_sum(float v) {
#pragma unroll
    for (int o = 1; o < 64; o <<= 1) v += __shfl_xor(v, o);
    return v;
}
__device__ __forceinline__ float sigmoid_f(float v) { return 1.f / (1.f + __expf(-v)); }
__device__ __forceinline__ float log_sigmoid_f(float v) { return fminf(v, 0.f) - log1pf(expf(-fabsf(v))); }

__device__ __forceinline__ void tr_item(const float* W, int ldw, int k0, int nsrc, bf16* WT, int ldt, int drow, int dk, LAS float* scr, int lane) {
#pragma unroll 8
    for (int i = 0; i < 32; ++i) { const int kk = 2 * i + (lane >> 5); scr[kk * 33 + (lane & 31)] = W[(size_t)(k0 + kk) * ldw + nsrc + (lane & 31)]; }
    LDS_WAIT(); asm volatile("" ::: "memory");
    const int c = lane & 7;
#pragma unroll
    for (int j = 0; j < 4; ++j) { const int n = (lane >> 3) + 8 * j; const LAS float* s = scr + (8 * c) * 33 + n;
        v4u o; o.x = pk2(s[0 * 33], s[1 * 33]); o.y = pk2(s[2 * 33], s[3 * 33]); o.z = pk2(s[4 * 33], s[5 * 33]); o.w = pk2(s[6 * 33], s[7 * 33]);
        *(GAS v4u*)(WT + (size_t)(drow + n) * ldt + dk + k0 + 8 * c) = o; }
    LDS_WAIT(); asm volatile("" ::: "memory");
}
__device__ __forceinline__ int win_src_col(int n0) {
    if (n0 < 512) return n0;
    if (n0 < 1024) return 1544 + (n0 - 512);
    if (n0 < 1536) return 512 + (n0 - 1024);
    if (n0 < 2048) return 2056 + (n0 - 1536);
    if (n0 < 2560) return 1024 + (n0 - 2048);
    if (n0 < 3072) return 2568 + (n0 - 2560);
    if (n0 < 4096) return 3080 + (n0 - 3072);
    return 4104 + (n0 - 4096);
}

struct Args { const float* in[19]; float* out; unsigned char* ws; int ph_lo, ph_hi; };

__global__ void __launch_bounds__(NWAVES * 64, 2) fwd(Args args) {
    extern __shared__ __attribute__((aligned(16))) unsigned char lds_raw[];
    Frame F;
    F.lds = (LAS unsigned char*)lds_raw;
    F.tid = threadIdx.x; F.lane = F.tid & 63; F.wave = __builtin_amdgcn_readfirstlane(F.tid >> 6);
    F.G = gridDim.x; { const int bx = blockIdx.x; F.vcu = (F.G % 8 == 0) ? (bx % 8) * (F.G / 8) + bx / 8 : bx; }
    unsigned char* ws = args.ws;
    unsigned* ctl = (unsigned*)(ws + WS_CTL);
    volatile LAS unsigned* MISC = (volatile LAS unsigned*)(F.lds + MISC_OFF);
    for (int u = F.tid; u < 256; u += NWAVES * 64) ((LAS unsigned*)(F.lds + MISC_OFF))[u] = 0u;
    __syncthreads();
    XcdBarrier bar = xcd_barrier_post(ctl + CW_BAR, MISC + 8);
    const int lo = args.ph_lo, hi = args.ph_hi;
#define IN(k) (lo <= (k) && (k) < hi)
#define BOTH(k) (IN(k) && IN((k) + 1))
    const int tid = F.tid, lane = F.lane, wave = F.wave;
    const int gw = F.vcu * NWAVES + wave, NGW = F.G * NWAVES;
    float* mod = (float*)(ws + WS_MOD);
    float* LOGF = (float*)(ws + WS_LOGF);
    float* FC = (float*)(ws + WS_F);
    bf16* WIN = (bf16*)(ws + WS_WIN); bf16* WBR = (bf16*)(ws + WS_WBR); bf16* WOUT = (bf16*)(ws + WS_WOUT); bf16* WGU = (bf16*)(ws + WS_WGU); bf16* WD = (bf16*)(ws + WS_WD);
    bf16* XN = (bf16*)(ws + WS_XN); bf16* QB = (bf16*)(ws + WS_Q); bf16* KB = (bf16*)(ws + WS_K); bf16* VB = (bf16*)(ws + WS_V); bf16* GAB = (bf16*)(ws + WS_GA); bf16* GBB = (bf16*)(ws + WS_GB);
    bf16* ACT = (bf16*)(ws + WS_ACT); bf16* YB = (bf16*)(ws + WS_Y);
    int* LIST = (int*)(ws + WS_LIST); float* LW = (float*)(ws + WS_LW);
    const float* x = args.in[0];

    if (IN(0)) {
        LAS float* cs = (LAS float*)F.lds;
        LAS float* red = (LAS float*)(F.lds + 32768);
        for (int i = tid; i < BATCH * D; i += NWAVES * 64) { const float v = args.in[1][i]; cs[i] = v / (1.f + expf(-v)); }
        __syncthreads();
        if (F.vcu < 192) {
            const int cc = tid & 31, ks = tid >> 5, col = F.vcu * 32 + cc;
            float a[8];
#pragma unroll
            for (int b = 0; b < 8; ++b) a[b] = 0.f;
            const float* wp = args.in[2] + col;
            for (int k = ks * 64; k < ks * 64 + 64; ++k) { const float w = wp[(size_t)k * (NMOD * D)];
#pragma unroll
                for (int b = 0; b < 8; ++b) a[b] += cs[b * D + k] * w; }
#pragma unroll
            for (int b = 0; b < 8; ++b) red[(ks * 8 + b) * 32 + cc] = a[b];
            __syncthreads();
            if (tid < 256) { const int b = tid >> 5; float s = 0.f;
#pragma unroll
                for (int q = 0; q < 16; ++q) s += red[(q * 8 + b) * 32 + cc];
                mod[b * (NMOD * D) + F.vcu * 32 + cc] = s + args.in[3][F.vcu * 32 + cc]; }
        }
        __syncthreads();
        LAS float* scr = (LAS float*)(F.lds + wave * 16384);
        constexpr int I_WIN = 16 * 160, I_BR = 8 * 32, I_OUT = 16 * 32, I_G = 16 * 256, I_D = 16 * 256;
        constexpr int NITEMS = I_WIN + 2 * I_BR + I_OUT + 2 * I_G + I_D;
        for (int it = gw; it < NITEMS; it += NGW) {
            int r = it;
            if (r < I_WIN) { const int kb = r / 160, nb = r % 160; tr_item(args.in[5], NIN, 64 * kb, win_src_col(32 * nb), WIN, D, 32 * nb, 0, scr, lane); continue; } r -= I_WIN;
            if (r < I_BR) { const int kb = r / 32, nb = r % 32; tr_item(args.in[7], D, 64 * kb, 32 * nb, WBR, D, 32 * nb, 0, scr, lane); continue; } r -= I_BR;
            if (r < I_BR) { const int kb = r / 32, nb = r % 32; tr_item(args.in[8], D, 64 * kb, 32 * nb, WBR, D, 32 * nb, 512, scr, lane); continue; } r -= I_BR;
            if (r < I_OUT) { const int kb = r / 32, nb = r % 32; tr_item(args.in[9], D, 64 * kb, 32 * nb, WOUT, D, 32 * nb, 0, scr, lane); continue; } r -= I_OUT;
            if (r < 2 * I_G) { const int up = r / I_G; r -= up * I_G; const int e = r / 256, q = r % 256, kb = q / 16, nb = q % 16, n0 = 32 * nb;
                tr_item(args.in[15 + up] + (size_t)e * D * DFF, DFF, 64 * kb, n0, WGU + (size_t)e * D * D, D, 256 * (n0 / 128) + (n0 % 128) + 128 * up, 0, scr, lane); continue; } r -= 2 * I_G;
            { const int e = r / 256, q = r % 256, kb = q / 32, nb = q % 32; tr_item(args.in[17] + (size_t)e * DFF * D, D, 64 * kb, 32 * nb, WD + (size_t)e * D * DFF, DFF, 32 * nb, 0, scr, lane); }
        }
        if (BOTH(0)) xcd_barrier(bar);
    }

    if (IN(1)) {
        for (int rb = F.vcu; rb < NTOK / 128; rb += F.G) {
        const int b = rb / 32;
        f32x4 wfa[16], wfb[16];
#pragma unroll
        for (int j = 0; j < 4; ++j)
#pragma unroll
            for (int c = 0; c < 4; ++c) { const int k = 4 * lane + 256 * j + c; wfa[4 * j + c] = *(const f32x4*)(args.in[5] + (size_t)k * NIN + 1536); wfb[4 * j + c] = *(const f32x4*)(args.in[5] + (size_t)k * NIN + 1540); }
        const float bfg = args.in[6][lane & 7];
        {
        for (int r = wave; r < 128; r += NWAVES) {
            const int m = rb * 128 + r;
            const GAS f32x4* xr = (const GAS f32x4*)(x + (size_t)m * D) + lane;
            f32x4 v[4]; float ss = 0.f;
#pragma unroll
            for (int j = 0; j < 4; ++j) { v[j] = xr[64 * j]; ss += (v[j].x * v[j].x + v[j].y * v[j].y) + (v[j].z * v[j].z + v[j].w * v[j].w); }
            const float rstd = 1.f / sqrtf(wave_sum(ss) * (1.f / D) + RMS_EPS);
            f32x4 fa0 = (f32x4){0.f, 0.f, 0.f, 0.f}, fa1 = fa0;
            GAS unsigned long long* o8 = (GAS unsigned long long*)(XN + (size_t)m * D) + lane;
#pragma unroll
            for (int j = 0; j < 4; ++j) { const int k = 4 * lane + 256 * j; const f32x4 g1 = *(const f32x4*)(args.in[4] + k), sc = *(const f32x4*)(mod + b * NMOD * D + D + k), sh = *(const f32x4*)(mod + b * NMOD * D + k);
                const f32x4 h = v[j] * rstd * (g1 * (sc + 1.f)) + sh;
                o8[64 * j] = (unsigned long long)pk2(h.x, h.y) | ((unsigned long long)pk2(h.z, h.w) << 32);
                fa0 += h.x * wfa[4 * j] + h.y * wfa[4 * j + 1] + h.z * wfa[4 * j + 2] + h.w * wfa[4 * j + 3];
                fa1 += h.x * wfb[4 * j] + h.y * wfb[4 * j + 1] + h.z * wfb[4 * j + 2] + h.w * wfb[4 * j + 3]; }
            float f[8] = {fa0.x, fa0.y, fa0.z, fa0.w, fa1.x, fa1.y, fa1.z, fa1.w};
#pragma unroll
            for (int q = 0; q < 8; ++q) f[q] = wave_sum(f[q]);
            const int hq = lane & 7; float val = f[0];
#pragma unroll
            for (int q = 1; q < 8; ++q) val = (hq == q) ? f[q] : val;
            if (lane < 8) LOGF[(size_t)(b * 8 + hq) * SEQ + (m % SEQ)] = log_sigmoid_f(val + bfg);
        }
        }
        }
        if (BOTH(1)) xcd_barrier(bar);
    }

    if (IN(2)) {
        for (int bh = F.vcu; bh < 64; bh += F.G) {
            LAS float* wt = (LAS float*)F.lds;
            const float* src = LOGF + (size_t)bh * SEQ + tid * 8; float* dst = FC + (size_t)bh * SEQ + tid * 8;
            const f32x4 a = *(const f32x4*)src, c = *(const f32x4*)(src + 4);
            float p[8]; p[0] = a.x; p[1] = p[0] + a.y; p[2] = p[1] + a.z; p[3] = p[2] + a.w; p[4] = p[3] + c.x; p[5] = p[4] + c.y; p[6] = p[5] + c.z; p[7] = p[6] + c.w;
            float incl = p[7];
#pragma unroll
            for (int o = 1; o < 64; o <<= 1) { const float t = __shfl_up(incl, o); if (lane >= o) incl += t; }
            if (lane == 63) wt[wave] = incl;
            __syncthreads();
            float base = incl - p[7];
            for (int w = 0; w < wave; ++w) base += wt[w];
            *(f32x4*)dst = (f32x4){p[0] + base, p[1] + base, p[2] + base, p[3] + base}; *(f32x4*)(dst + 4) = (f32x4){p[4] + base, p[5] + base, p[6] + base, p[7] + base};
            __syncthreads();
        }
        pg8::Gemm g{XN, WIN, D, D, D}; pg8::StaticOrder S; S.init(NTOK, NP1, F.G, (int)blockIdx.x);
        pg8::EpiSplit E{QB, D, D, (size_t)(WS_K - WS_Q) / 2, C2, ctl + CW_KMAX};
        pg8::gemm_phase<pg8::EpiSplit, pg8::StaticOrder, true, false>(F.lds, g, S, E, nullptr);
        if (BOTH(2)) xcd_barrier(bar);
    }

    if (IN(3)) {
        LAS unsigned char* vl = F.lds + wave * 16384;
        for (int uid = F.vcu; uid < 2048; uid += F.G) {
            const int type = uid >> 10, idx = uid & 1023, bh = idx >> 4, b = bh >> 3, h = bh & 7, q0 = (idx & 15) * 256 + wave * 32;
            if (type == 0) {
                const float k2 = __builtin_bit_cast(float, __hip_atomic_load(ctl + CW_KMAX + bh * 2, __ATOMIC_RELAXED, __HIP_MEMORY_SCOPE_AGENT)) + __builtin_bit_cast(float, __hip_atomic_load(ctl + CW_KMAX + bh * 2 + 1, __ATOMIC_RELAXED, __HIP_MEMORY_SCOPE_AGENT));
                att::attn_wave<false>(b, h * 64, q0, QB, KB, VB, QB, FC + (size_t)bh * SEQ, k2, vl, lane);
            } else {
                att::attn_wave<true>(b, 512 + h * 64, q0, QB, KB, VB, QB, nullptr, 0.f, vl, lane);
            }
        }
        if (BOTH(3)) xcd_barrier(bar);
    }

    if (IN(4)) {
        pg8::Gemm g{QB, WBR, D, D, D}; pg8::StaticOrder S; S.init(NTOK, D, F.G, (int)blockIdx.x);
        pg8::EpiMerge E{GAB, GBB, KB};
        pg8::gemm_phase<pg8::EpiMerge, pg8::StaticOrder, true, false>(F.lds, g, S, E, nullptr);
        if (BOTH(4)) xcd_barrier(bar);
    }

    if (IN(5)) {
        pg8::Gemm g{KB, WOUT, D, D, D}; pg8::StaticOrder S; S.init(NTOK, D, F.G, (int)blockIdx.x);
        pg8::EpiResid E{x, mod + 2 * D, args.out};
        pg8::gemm_phase<pg8::EpiResid, pg8::StaticOrder, true, false>(F.lds, g, S, E, nullptr);
        if (BOTH(5)) xcd_barrier(bar);
    }

    if (IN(6)) {
        LAS float* wr = (LAS float*)F.lds;
        LAS float* rscr = (LAS float*)(F.lds + 81920) + wave * 128;
        LAS int* selE = (LAS int*)(F.lds + 81920 + 8 * 512);
        LAS float* selW = (LAS float*)(F.lds + 81920 + 8 * 512 + 512);
        LAS int* lcnt = (LAS int*)(F.lds + 81920 + 8 * 512 + 512 + 1024);
        LAS int* lpos = lcnt + 32;
        for (int k = tid; k < D; k += NWAVES * 64) {
            const f32x4 g4 = *(const f32x4*)(args.in[11] + (size_t)k * 4);
            wr[0 * D + k] = g4.x; wr[1 * D + k] = g4.y; wr[2 * D + k] = g4.z; wr[3 * D + k] = g4.w;
#pragma unroll
            for (int q = 0; q < 4; ++q) { const f32x4 e4 = *(const f32x4*)(args.in[13] + (size_t)k * 16 + 4 * q);
                wr[(4 + 4 * q) * D + k] = e4.x; wr[(5 + 4 * q) * D + k] = e4.y; wr[(6 + 4 * q) * D + k] = e4.z; wr[(7 + 4 * q) * D + k] = e4.w; }
        }
        for (int rb = F.vcu; rb < NTOK / 128; rb += F.G) {
        if (tid < 32) lcnt[tid] = 0;
        __syncthreads();
        const int b = rb / 32;
        f32x4 gs[4], sh[4];
#pragma unroll
        for (int j = 0; j < 4; ++j) { const int k = 4 * lane + 256 * j; const f32x4 g2 = *(const f32x4*)(args.in[10] + k), sc = *(const f32x4*)(mod + b * NMOD * D + 4 * D + k); sh[j] = *(const f32x4*)(mod + b * NMOD * D + 3 * D + k); gs[j] = g2 * (sc + 1.f); }
        for (int rg = 0; rg < 4; ++rg) {
            const int rl0 = wave * 16 + rg * 4;
            f32x4 hv[4][4];
#pragma unroll
            for (int r = 0; r < 4; ++r) { const int m = rb * 128 + rl0 + r;
                const GAS f32x4* xr = (const GAS f32x4*)(args.out + (size_t)m * D) + lane; float ss = 0.f;
#pragma unroll
                for (int j = 0; j < 4; ++j) { hv[r][j] = xr[64 * j]; ss += (hv[r][j].x * hv[r][j].x + hv[r][j].y * hv[r][j].y) + (hv[r][j].z * hv[r][j].z + hv[r][j].w * hv[r][j].w); }
                const float rstd = 1.f / sqrtf(wave_sum(ss) * (1.f / D) + RMS_EPS);
                GAS unsigned long long* o8 = (GAS unsigned long long*)(XN + (size_t)m * D) + lane;
#pragma unroll
                for (int j = 0; j < 4; ++j) { hv[r][j] = hv[r][j] * rstd * gs[j] + sh[j];
                    o8[64 * j] = (unsigned long long)pk2(hv[r][j].x, hv[r][j].y) | ((unsigned long long)pk2(hv[r][j].z, hv[r][j].w) << 32); } }
            float a[80];
#pragma unroll
            for (int i = 0; i < 80; ++i) a[i] = 0.f;
#pragma unroll
            for (int qq = 0; qq < 20; ++qq)
#pragma unroll
                for (int j = 0; j < 4; ++j) { const f32x4 w = *(const LAS f32x4*)(wr + qq * D + 256 * j + 4 * lane);
#pragma unroll
                    for (int r = 0; r < 4; ++r) { const int idx = 16 * (qq >> 2) + 4 * (qq & 3) + r;
                        a[idx] += (hv[r][j].x * w.x + hv[r][j].y * w.y) + (hv[r][j].z * w.z + hv[r][j].w * w.w); } }
            float b40[40], b20[20], b10[10], b5[5];
            { const bool up = (lane & 32) != 0;
#pragma unroll
              for (int i = 0; i < 5; ++i)
#pragma unroll
                for (int c = 0; c < 8; ++c) { const float lo_ = a[16 * i + c], hi_ = a[16 * i + c + 8]; const float snd = up ? lo_ : hi_, kp = up ? hi_ : lo_; b40[8 * i + c] = kp + __shfl_xor(snd, 32); } }
            { const bool up = (lane & 16) != 0;
#pragma unroll
              for (int i = 0; i < 5; ++i)
#pragma unroll
                for (int c = 0; c < 4; ++c) { const float lo_ = b40[8 * i + c], hi_ = b40[8 * i + c + 4]; const float snd = up ? lo_ : hi_, kp = up ? hi_ : lo_; b20[4 * i + c] = kp + __shfl_xor(snd, 16); } }
            { const bool up = (lane & 8) != 0;
#pragma unroll
              for (int i = 0; i < 5; ++i)
#pragma unroll
                for (int c = 0; c < 2; ++c) { const float lo_ = b20[4 * i + c], hi_ = b20[4 * i + c + 2]; const float snd = up ? lo_ : hi_, kp = up ? hi_ : lo_; b10[2 * i + c] = kp + __shfl_xor(snd, 8); } }
            { const bool up = (lane & 4) != 0;
#pragma unroll
              for (int i = 0; i < 5; ++i) { const float lo_ = b10[2 * i], hi_ = b10[2 * i + 1]; const float snd = up ? lo_ : hi_, kp = up ? hi_ : lo_; b5[i] = kp + __shfl_xor(snd, 4); } }
#pragma unroll
            for (int i = 0; i < 5; ++i) { b5[i] += __shfl_xor(b5[i], 1); b5[i] += __shfl_xor(b5[i], 2); }
            { const int c = (lane >> 2) & 15;
              if ((lane & 3) == 0) {
#pragma unroll
                  for (int i = 0; i < 5; ++i) rscr[(c & 3) * 20 + 4 * i + (c >> 2)] = b5[i]; } }
            LDS_WAIT(); asm volatile("" ::: "memory");
            if (lane < 4) {
                float lg[20];
#pragma unroll
                for (int i = 0; i < 20; ++i) lg[i] = rscr[lane * 20 + i];
#pragma unroll
                for (int i = 0; i < 4; ++i) lg[i] += args.in[12][i];
#pragma unroll
                for (int i = 0; i < 16; ++i) lg[4 + i] += args.in[14][i];
                int gi = 0; float gm = lg[0];
#pragma unroll
                for (int i = 1; i < 4; ++i) if (lg[i] > gm) { gm = lg[i]; gi = i; }
                float gsum = 0.f;
#pragma unroll
                for (int i = 0; i < 4; ++i) gsum += expf(lg[i] - gm);
                const float gp = 1.f / gsum;
                float es[4];
#pragma unroll
                for (int i = 0; i < 4; ++i) es[i] = (gi == 0) ? lg[4 + i] : (gi == 1) ? lg[8 + i] : (gi == 2) ? lg[12 + i] : lg[16 + i];
                int i1 = 0; float m1 = es[0];
#pragma unroll
                for (int i = 1; i < 4; ++i) if (es[i] > m1) { m1 = es[i]; i1 = i; }
                int i2 = -1; float m2 = -3.0e38f;
#pragma unroll
                for (int i = 0; i < 4; ++i) if (i != i1 && es[i] > m2) { m2 = es[i]; i2 = i; }
                const float p2 = expf(m2 - m1), inv = 1.f / (1.f + p2);
                const int rl = rl0 + lane;
                selE[rl] = (gi * 4 + i1) | ((gi * 4 + i2) << 8); selW[2 * rl] = gp * inv; selW[2 * rl + 1] = gp * p2 * inv;
            }
            LDS_WAIT(); asm volatile("" ::: "memory");
        }
        __syncthreads();
        int my_e = 0;
        if (tid < 256) { const int se = selE[tid >> 1]; my_e = (tid & 1) ? (se >> 8) & 255 : se & 255; lpos[tid] = __hip_atomic_fetch_add(&lcnt[my_e], 1, __ATOMIC_RELAXED, __HIP_MEMORY_SCOPE_WORKGROUP); }
        __syncthreads();
        if (tid < 16) lcnt[16 + tid] = (int)__hip_atomic_fetch_add(ctl + CW_CNT + 64 * tid, (unsigned)lcnt[tid], __ATOMIC_RELAXED, __HIP_MEMORY_SCOPE_AGENT);
        __syncthreads();
        if (tid < 256) { const int pos = lcnt[16 + my_e] + lpos[tid]; LIST[my_e * NTOK + pos] = (rb * 128 + (tid >> 1)) * 2 + (tid & 1); LW[my_e * NTOK + pos] = selW[tid]; }
        __syncthreads();
        }
        if (BOTH(6)) xcd_barrier(bar);
    }

    LAS int* tab = (LAS int*)(F.lds + TAB_OFF);
    LAS int* gtab = (LAS int*)(F.lds + TAB_OFF + 256);
    if (IN(7) || IN(8)) {
        if (tid == 0) { int acc_t = 0;
            for (int e = 0; e < 16; ++e) { const int c = (int)__hip_atomic_load(ctl + CW_CNT + 64 * e, __ATOMIC_RELAXED, __HIP_MEMORY_SCOPE_AGENT); tab[e] = acc_t; tab[32 + e] = c; acc_t += (c + 255) >> 8; }
            tab[16] = acc_t; }
        __syncthreads();
    }
    if (IN(7)) {
        pg8::MoeOrder S{tab, F.G, F.vcu, (size_t)D * D * 2, true};
        { pg8::Unit u;
          for (int i = 0; i < 14; ++i) { if (!S.next(i, u)) break;
              if (tid < 256) { const int pos = u.row0 + tid; gtab[i * 256 + tid] = (pos < tab[32 + u.e]) ? (LIST[u.e * NTOK + pos] >> 1) : 0; } } }
        __syncthreads();
        pg8::Gemm g{XN, WGU, D, D, D};
        pg8::EpiAct E{ACT};
        pg8::gemm_phase<pg8::EpiAct, pg8::MoeOrder, true, true>(F.lds, g, S, E, gtab);
        if (BOTH(7)) xcd_barrier(bar);
    }
    if (IN(8)) {
        pg8::MoeOrder S{tab, F.G, F.vcu, (size_t)D * DFF * 2, false};
        pg8::Gemm g{ACT, WD, DFF, DFF, DFF};
        pg8::EpiDown E{LIST, LW, tab, YB};
        pg8::gemm_phase<pg8::EpiDown, pg8::MoeOrder, true, false>(F.lds, g, S, E, nullptr);
        if (BOTH(8)) xcd_barrier(bar);
    }
    if (IN(9)) {
        for (int rb = F.vcu; rb < NTOK / 128; rb += F.G) {
        const int b = rb / 32;
        f32x4 g2[4], fg[4];
#pragma unroll
        for (int j = 0; j < 4; ++j) { const int k = 4 * lane + 256 * j; g2[j] = *(const f32x4*)(mod + b * NMOD * D + 5 * D + k); fg[j] = *(const f32x4*)(args.in[18] + k); }
        {
        for (int r = wave; r < 128; r += NWAVES) {
            const int m = rb * 128 + r;
            GAS f32x4* xr = (GAS f32x4*)(args.out + (size_t)m * D) + lane;
            const GAS v2u* y0 = (const GAS v2u*)(YB + (size_t)m * D) + lane; const GAS v2u* y1 = (const GAS v2u*)(YB + (size_t)(NTOK + m) * D) + lane;
            f32x4 v[4]; float ss = 0.f;
#pragma unroll
            for (int j = 0; j < 4; ++j) { const v2u a = y0[64 * j], c = y1[64 * j];
                const f32x4 ys = (f32x4){bflo(a.x) + bflo(c.x), bfhi(a.x) + bfhi(c.x), bflo(a.y) + bflo(c.y), bfhi(a.y) + bfhi(c.y)};
                v[j] = xr[64 * j] + g2[j] * ys; ss += (v[j].x * v[j].x + v[j].y * v[j].y) + (v[j].z * v[j].z + v[j].w * v[j].w); }
            const float rstd = 1.f / sqrtf(wave_sum(ss) * (1.f / D) + RMS_EPS);
#pragma unroll
            for (int j = 0; j < 4; ++j) xr[64 * j] = v[j] * rstd * fg[j];
        }
        }
        }
    }
#undef IN
#undef BOTH
}

extern "C" void kernel_launch(void* const* d_in, const int* in_sizes, int n_in, void* d_out, int out_size, void* d_ws, size_t ws_size, hipStream_t stream) {
    static int grid = 0;
    if (grid == 0) {
        if (n_in != 19 || in_sizes[0] != NTOK * D || out_size != NTOK * D || ws_size < WS_END) { fprintf(stderr, "kernel_launch: unexpected problem shape (n_in %d, ws %zu)\n", n_in, ws_size); grid = -1; return; }
        int dev = 0, cus = 0, per_cu = 0;
        if (hipGetDevice(&dev) != hipSuccess || hipDeviceGetAttribute(&cus, hipDeviceAttributeMultiprocessorCount, dev) != hipSuccess) { grid = -1; return; }
        if (hipFuncSetAttribute((const void*)fwd, hipFuncAttributeMaxDynamicSharedMemorySize, LDS_BYTES) != hipSuccess) { grid = -1; return; }
        if (hipOccupancyMaxActiveBlocksPerMultiprocessor(&per_cu, (const void*)fwd, NWAVES * 64, LDS_BYTES) != hipSuccess || per_cu < 1) { fprintf(stderr, "kernel_launch: occupancy query reports %d\n", per_cu); }
        (void)hipGetLastError();
        grid = cus;
    }
    if (grid < 0) return;
    if (hipMemsetAsync((char*)d_ws + WS_CTL, 0, CTL_ZERO_BYTES, stream) != hipSuccess) return;
    Args a{};
    for (int i = 0; i < 19; ++i) a.in[i] = (const float*)d_in[i];
    a.out = (float*)d_out; a.ws = (unsigned char*)d_ws; a.ph_lo = 0; a.ph_hi = 10;
    hipLaunchKernelGGL(fwd, dim3(grid), dim3(NWAVES * 64), LDS_BYTES, stream, a);
}
```

```cpp
#include <hip/hip_runtime.h>
#include <cstdio>
#include <cstdint>

#define GAS __attribute__((address_space(1)))
#define LAS __attribute__((address_space(3)))
typedef unsigned short bf16;
typedef unsigned v4u __attribute__((ext_vector_type(4)));
typedef unsigned v2u __attribute__((ext_vector_type(2)));
typedef float f32x4 __attribute__((ext_vector_type(4)));
typedef float f32x2 __attribute__((ext_vector_type(2)));
typedef short bf16x8 __attribute__((ext_vector_type(8)));

#define GREP2 1
#define GREP4 1
#define GREP5 1
#define GREP7 1
#define GREP8 1
#define PROBE_EPI 0
#define PROBE_ATT 0
#define PROBE_P1 0
#define NREP0 1
#define NREP1 1
#define NREP2 1
#define NREP3 1
#define NREP4 1
#define NREP5 1
#define NREP6 1
#define NREP7 1
#define NREP8 1
#define NREP9 1
constexpr int BATCH = 8, SEQ = 4096, D = 1024, NTOK = BATCH * SEQ, HD = 64;
constexpr int NIN = 5128, NP1 = 5120, NE = 16, DFF = 512, NMOD = 6;
constexpr float RMS_EPS = 1e-6f;
constexpr float LOG2E = 1.4426950408889634f;
constexpr float C2 = 0.125f * 1.4426950408889634f;
constexpr int NWAVES = 8;

constexpr size_t MiB = 1u << 20;
constexpr size_t WS_CTL = 0, CTL_ZERO_BYTES = 128 * 1024;
constexpr size_t WS_MOD = 1 * MiB;
constexpr size_t WS_LOGF = 1 * MiB + 256 * 1024;
constexpr size_t WS_F = 2 * MiB + 256 * 1024;
constexpr size_t WS_LIST = 4 * MiB;
constexpr size_t WS_LW = 6 * MiB;
constexpr size_t WS_WIN = 8 * MiB;
constexpr size_t WS_WBR = 18 * MiB;
constexpr size_t WS_WOUT = 20 * MiB;
constexpr size_t WS_WGU = 22 * MiB;
constexpr size_t WS_WD = 54 * MiB;
constexpr size_t WS_XN = 72 * MiB;
constexpr size_t WS_Q = 136 * MiB;
constexpr size_t WS_K = 200 * MiB;
constexpr size_t WS_V = 264 * MiB;
constexpr size_t WS_GA = 328 * MiB;
constexpr size_t WS_GB = 392 * MiB;
constexpr size_t WS_ACT = 136 * MiB;
constexpr size_t WS_Y = 328 * MiB;
constexpr size_t WS_XN8 = 456 * MiB;
constexpr size_t WS_WIN8 = 38 * MiB;
constexpr size_t WS_END = 488 * MiB;
constexpr int CW_BAR = 4096;
constexpr int CW_CNT = 16384;
constexpr int CW_MODCNT = 24576;
static_assert((CW_MODCNT + 64) * 4 <= 128 * 1024, "control words inside the per-call memset");
constexpr int CW_KMAX = 20480;

constexpr int RING_BYTES = 131072;
constexpr int MISC_OFF = RING_BYTES;
constexpr int TAB_OFF = RING_BYTES + 1024;
constexpr int LDS_BYTES = 147456;

__device__ __forceinline__ unsigned f2bf(float f) { unsigned u = __builtin_bit_cast(unsigned, f); return (u + 0x7fffu + ((u >> 16) & 1u)) >> 16; }
__device__ __forceinline__ unsigned pk2(float lo, float hi) { typedef float f2_ __attribute__((ext_vector_type(2))); typedef __bf16 b2_ __attribute__((ext_vector_type(2))); f2_ v = {lo, hi}; b2_ b = __builtin_convertvector(v, b2_); return __builtin_bit_cast(unsigned, b); }
__device__ __forceinline__ float bflo(unsigned w) { return __builtin_bit_cast(float, w << 16); }
__device__ __forceinline__ float bfhi(unsigned w) { return __builtin_bit_cast(float, w & 0xffff0000u); }
#define LDS_WAIT() asm volatile("s_waitcnt lgkmcnt(0)" ::: "memory")
#define VM_WAIT() asm volatile("s_waitcnt vmcnt(0)" ::: "memory")

namespace pg8 {
#define PG8_LAS __attribute__((address_space(3)))
typedef unsigned short bf16_t;
typedef unsigned u32x4 __attribute__((ext_vector_type(4)));
constexpr int BM = 256, BK = 64, HALF = 128, HTB = HALF * BK * 2, STAGE_BYTES = 8 * HTB, NXCD = 8, WGM = 8;

__host__ __device__ __forceinline__ int lds_byte(int r, int c) { const int st = (r >> 4) * 2 + (c >> 5), rr = r & 15, cc = c & 31, ob = rr * 64 + cc * 2; return st * 1024 + (ob ^ (((ob >> 9) & 1) << 5)); }
__host__ __device__ __forceinline__ void stage_rc(int b, int& R, int& C) { const int st = b / 1024, sb = b % 1024, swz = sb ^ (((sb >> 9) & 1) << 5); R = (st >> 1) * 16 + swz / 64; C = (st & 1) * 32 + (swz % 64) / 2; }
__host__ __device__ __forceinline__ int perm32(int rho) { const int n = rho >> 4, i = rho & 15; return 8 * (i >> 2) + 4 * n + (i & 3); }

struct Unit { int pm, pn, e, row0; };
typedef int v4i32x __attribute__((ext_vector_type(4)));
struct Gemm { const bf16_t* A; const bf16_t* Bt; int K, lda, ldb; int sa, sb; };
typedef int v8i32 __attribute__((ext_vector_type(8)));
typedef int v4i32 __attribute__((ext_vector_type(4)));

struct StaticOrder {
    int nM, nN, nwg, G, c, reps;
    __device__ void init(int M, int N, int G_, int c_, int reps_ = 1) { nM = M / BM; nN = N / BM; nwg = nM * nN; G = G_; c = c_; reps = reps_; }
    __device__ __forceinline__ bool next(int i, Unit& u) const {
        long L = (long)i * G + c; if (L >= (long)nwg * reps) return false;
        u.e = (L >= nwg) ? 1 : 0;
        L %= nwg;
        int wgid = (int)L; { const int q = nwg / NXCD, r = nwg % NXCD, xcd = wgid % NXCD, off = wgid / NXCD; wgid = (xcd < r ? xcd * (q + 1) : r * (q + 1) + (xcd - r) * q) + off; }
        const int nig = WGM * nN, gid = wgid / nig, fm = gid * WGM, gsz = (nM - fm) < WGM ? (nM - fm) : WGM;
        u.pm = fm + ((wgid % nig) % gsz); u.pn = (wgid % nig) / gsz; u.row0 = (int)L; return true;
    }
    __device__ __forceinline__ const char* abase(const Gemm& g, const Unit& u) const { return (const char*)g.A + (size_t)u.pm * BM * g.lda * 2; }
    __device__ __forceinline__ const char* bbase(const Gemm& g, const Unit& u) const { return (const char*)g.Bt + (size_t)u.pn * BM * g.ldb * 2; }
};
struct GateOrder {
    StaticOrder M;
    __device__ __forceinline__ bool next(int i, Unit& u) const { if (!M.next(i >> 1, u)) return false; u.pn += 4 * (i & 1); u.row0 = u.row0 * 2 + (i & 1); return true; }
    __device__ __forceinline__ const char* abase(const Gemm& g, const Unit& u) const { return (const char*)g.A + (size_t)u.pm * BM * g.lda * 2; }
    __device__ __forceinline__ const char* bbase(const Gemm& g, const Unit& u) const { return (const char*)g.Bt + (size_t)u.pn * BM * g.ldb * 2; }
};
struct MoeOrder {
    const PG8_LAS int* ul; size_t estride; bool gatherA;
    __device__ __forceinline__ bool next(int i, Unit& u) const {
        unsigned a0 = (unsigned)(size_t)ul; asm volatile("" : "+s"(a0));
        const int n = __builtin_amdgcn_readfirstlane(*(const PG8_LAS int*)(size_t)a0); if (i >= n) return false;
        const v4i32x q = *(const PG8_LAS v4i32x*)(size_t)(a0 + 16u + 16u * (unsigned)i);
        u.pm = __builtin_amdgcn_readfirstlane(q.x); u.pn = __builtin_amdgcn_readfirstlane(q.y); u.e = __builtin_amdgcn_readfirstlane(q.z); u.row0 = __builtin_amdgcn_readfirstlane(q.w); return true;
    }
    __device__ __forceinline__ const char* abase(const Gemm& g, const Unit& u) const { return gatherA ? (const char*)g.A : (const char*)g.A + (size_t)u.pm * BM * g.lda * 2; }
    __device__ __forceinline__ const char* bbase(const Gemm& g, const Unit& u) const { return (const char*)g.Bt + (size_t)u.e * estride + (size_t)u.pn * BM * g.ldb * 2; }
};

__device__ __forceinline__ unsigned cvt_pk_bf16(float lo, float hi) { typedef float f2_ __attribute__((ext_vector_type(2))); typedef __bf16 b2_ __attribute__((ext_vector_type(2))); f2_ v = {lo, hi}; b2_ b = __builtin_convertvector(v, b2_); return __builtin_bit_cast(unsigned, b); }

struct EpiSplit {
    static constexpr bool PERM = true, HAS_MID = false; static constexpr bool PERM16 = false;
    bf16_t* O; int ldc; int split_cols; size_t split_stride; float scale0; unsigned* kmax; float sall; bool sig;
    __device__ __forceinline__ void operator()(const f32x4 (&acc)[2][2][4][2], const Unit& u, int wr, int wc, int fr, int fq) const {
        const int row0 = u.pm * BM + wr * 64 + fr; int colt = u.pn * BM; bf16_t* base = O;
        float sc = sall; const int tsplit = colt / split_cols; { const int t = tsplit; base += (size_t)t * split_stride; colt -= t * split_cols; if (t == 0) sc *= scale0; }
        if (kmax != nullptr && tsplit == 1 && colt < 512) {
#pragma unroll
            for (int bj = 0; bj < 2; ++bj) { float mxv = 0.f;
#pragma unroll
                for (int ai = 0; ai < 2; ++ai)
#pragma unroll
                    for (int m = 0; m < 4; ++m) { const f32x4 a = acc[ai][bj][m][0], c = acc[ai][bj][m][1];
                        float q = (a[0] * a[0] + a[1] * a[1]) + (a[2] * a[2] + a[3] * a[3]) + (c[0] * c[0] + c[1] * c[1]) + (c[2] * c[2] + c[3] * c[3]);
                        q += __shfl_xor(q, 16); q += __shfl_xor(q, 32); mxv = fmaxf(mxv, q); }
                mxv = fmaxf(mxv, __shfl_xor(mxv, 1)); mxv = fmaxf(mxv, __shfl_xor(mxv, 2)); mxv = fmaxf(mxv, __shfl_xor(mxv, 4)); mxv = fmaxf(mxv, __shfl_xor(mxv, 8));
                if (fr == 0 && fq == 0) { const int head = (colt >> 6) + 2 * bj + (wc >> 1), b = (u.pm * BM) / SEQ;
                    __hip_atomic_fetch_max(kmax + ((b * 8 + head) * 2 + (wc & 1)), __builtin_bit_cast(unsigned, mxv), __ATOMIC_RELAXED, __HIP_MEMORY_SCOPE_AGENT); } }
        }
        const int col0 = colt + wc * 32 + 8 * fq;
#pragma unroll
        for (int ai = 0; ai < 2; ++ai)
#pragma unroll
            for (int m = 0; m < 4; ++m) { bf16_t* rowp = base + (size_t)(row0 + ai * HALF + m * 16) * ldc + col0;
#pragma unroll
                for (int bj = 0; bj < 2; ++bj) { f32x4 v0 = acc[ai][bj][m][0] * sc, v1 = acc[ai][bj][m][1] * sc;
                    if (sig) {
#pragma unroll
                        for (int j = 0; j < 4; ++j) { v0[j] = __builtin_amdgcn_rcpf(1.f + __expf(-v0[j])); v1[j] = __builtin_amdgcn_rcpf(1.f + __expf(-v1[j])); } }
                    u32x4 w; w.x = cvt_pk_bf16(v0[0], v0[1]); w.y = cvt_pk_bf16(v0[2], v0[3]); w.z = cvt_pk_bf16(v1[0], v1[1]); w.w = cvt_pk_bf16(v1[2], v1[3]);
                    *(u32x4*)(rowp + bj * HALF) = w; } }
    }
    __device__ __forceinline__ void mid(f32x4 (&)[2][2][4][2], const Unit&, int, int, int, int) const {}
};
struct EpiGate8 {
    static constexpr bool PERM = true, HAS_MID = false; static constexpr bool PERM16 = false;
    unsigned char* G8; float scale;
    __device__ __forceinline__ void operator()(const f32x4 (&acc)[2][2][4][2], const Unit& u, int wr, int wc, int fr, int fq) const {
        unsigned char* base = G8 + (size_t)u.row0 * 65536 + (wr * 4 + wc) * 8192 + (fq * 16 + fr) * 16;
#pragma unroll
        for (int ai = 0; ai < 2; ++ai)
#pragma unroll
            for (int m = 0; m < 4; ++m) { unsigned w[2][2];
#pragma unroll
                for (int bj = 0; bj < 2; ++bj)
#pragma unroll
                    for (int n = 0; n < 2; ++n) { unsigned q[4];
#pragma unroll
                        for (int j = 0; j < 4; ++j) { const float sg = __builtin_amdgcn_rcpf(1.f + __expf(-acc[ai][bj][m][n][j] * scale)); q[j] = (unsigned)fminf(fmaxf(sg * 255.f + 0.5f, 1.f), 255.f); }
                        w[bj][n] = q[0] | (q[1] << 8) | (q[2] << 16) | (q[3] << 24); }
                *(u32x4*)(base + (ai * 4 + m) * 1024) = (u32x4){w[0][0], w[0][1], w[1][0], w[1][1]}; }
    }
    __device__ __forceinline__ void mid(f32x4 (&)[2][2][4][2], const Unit&, int, int, int, int) const {}
};
struct EpiMerge {
    static constexpr bool PERM = true, HAS_MID = true; static constexpr bool PERM16 = false;
    const unsigned char* G8; bf16_t* O;
    __device__ __forceinline__ void mid(f32x4 (&acc)[2][2][4][2], const Unit& u, int wr, int wc, int fr, int fq) const {
        if (PROBE_EPI && u.e) return;
        const unsigned char* sa = G8 + (size_t)u.row0 * 131072 + (wr * 4 + wc) * 8192 + (fq * 16 + fr) * 16;
        u32x4 ga[2][4], gb[2][4];
#pragma unroll
        for (int ai = 0; ai < 2; ++ai)
#pragma unroll
            for (int m = 0; m < 4; ++m) { ga[ai][m] = *(const u32x4*)(sa + (ai * 4 + m) * 1024); gb[ai][m] = *(const u32x4*)(sa + 65536 + (ai * 4 + m) * 1024); }
#pragma unroll
        for (int ai = 0; ai < 2; ++ai)
#pragma unroll
            for (int m = 0; m < 4; ++m)
#pragma unroll
                for (int bj = 0; bj < 2; ++bj)
#pragma unroll
                    for (int n = 0; n < 2; ++n) { const unsigned a = ga[ai][m][bj * 2 + n], b = gb[ai][m][bj * 2 + n]; f32x4 r;
#pragma unroll
                        for (int j = 0; j < 4; ++j) r[j] = (float)((a >> (8 * j)) & 255u) * __builtin_amdgcn_rcpf((float)((b >> (8 * j)) & 255u));
                        acc[ai][bj][m][n] = acc[ai][bj][m][n] * r; }
    }
    __device__ __forceinline__ void operator()(const f32x4 (&acc)[2][2][4][2], const Unit& u, int wr, int wc, int fr, int fq) const {
        if (PROBE_EPI && u.e) return;
        const int row0 = u.pm * BM + wr * 64 + fr, col0 = u.pn * BM + wc * 32 + 8 * fq;
        const unsigned char* sb = G8 + (size_t)u.row0 * 131072 + 65536 + (wr * 4 + wc) * 8192 + (fq * 16 + fr) * 16;
        u32x4 gb[2][4];
#pragma unroll
        for (int ai = 0; ai < 2; ++ai)
#pragma unroll
            for (int m = 0; m < 4; ++m) gb[ai][m] = *(const u32x4*)(sb + (ai * 4 + m) * 1024);
        asm volatile("" ::: "memory");
#pragma unroll
        for (int ai = 0; ai < 2; ++ai)
#pragma unroll
            for (int m = 0; m < 4; ++m) { const size_t ro = (size_t)(row0 + ai * HALF + m * 16) * D + col0;
#pragma unroll
                for (int bj = 0; bj < 2; ++bj) { f32x4 v[2];
#pragma unroll
                    for (int n = 0; n < 2; ++n) { const unsigned b = gb[ai][m][bj * 2 + n]; f32x4 sg;
#pragma unroll
                        for (int j = 0; j < 4; ++j) sg[j] = (float)((b >> (8 * j)) & 255u) * (1.f / 255.f);
                        v[n] = acc[ai][bj][m][n] * sg; }
                    u32x4 w; w.x = cvt_pk_bf16(v[0][0], v[0][1]); w.y = cvt_pk_bf16(v[0][2], v[0][3]); w.z = cvt_pk_bf16(v[1][0], v[1][1]); w.w = cvt_pk_bf16(v[1][2], v[1][3]);
                    *(u32x4*)(O + ro + bj * HALF) = w; } }
    }
};
struct EpiResid {
    static constexpr bool PERM = true, HAS_MID = false; static constexpr bool PERM16 = false;
    const float* X; const float* gate; bf16_t* O; float* SSQ;
    __device__ __forceinline__ void operator()(const f32x4 (&acc)[2][2][4][2], const Unit& u, int wr, int wc, int fr, int fq) const {
        if (PROBE_EPI && u.e) return;
        const int row0 = u.pm * BM + wr * 64 + fr, col0 = u.pn * BM + wc * 32 + 8 * fq; const int b = (u.pm * BM) / SEQ;
        f32x4 gv[2][2];
#pragma unroll
        for (int bj = 0; bj < 2; ++bj)
#pragma unroll
            for (int n = 0; n < 2; ++n) gv[bj][n] = *(const f32x4*)(gate + (size_t)b * NMOD * D + col0 + bj * HALF + n * 4);
#pragma unroll
        for (int ai = 0; ai < 2; ++ai) {
            f32x4 xv[4][2][2];
#pragma unroll
            for (int m = 0; m < 4; ++m) { const size_t ro = (size_t)(row0 + ai * HALF + m * 16) * D + col0;
#pragma unroll
                for (int bj = 0; bj < 2; ++bj)
#pragma unroll
                    for (int n = 0; n < 2; ++n) xv[m][bj][n] = *(const f32x4*)(X + ro + bj * HALF + n * 4); }
            asm volatile("" ::: "memory");
#pragma unroll
            for (int m = 0; m < 4; ++m) { const size_t ro = (size_t)(row0 + ai * HALF + m * 16) * D + col0; float sq = 0.f;
#pragma unroll
                for (int bj = 0; bj < 2; ++bj) { const f32x4 o0 = xv[m][bj][0] + gv[bj][0] * acc[ai][bj][m][0], o1 = xv[m][bj][1] + gv[bj][1] * acc[ai][bj][m][1];
                    u32x4 w; w.x = cvt_pk_bf16(o0[0], o0[1]); w.y = cvt_pk_bf16(o0[2], o0[3]); w.z = cvt_pk_bf16(o1[0], o1[1]); w.w = cvt_pk_bf16(o1[2], o1[3]);
                    *(u32x4*)(O + ro + bj * HALF) = w;
                    sq += ((o0[0] * o0[0] + o0[1] * o0[1]) + (o0[2] * o0[2] + o0[3] * o0[3])) + ((o1[0] * o1[0] + o1[1] * o1[1]) + (o1[2] * o1[2] + o1[3] * o1[3])); }
                sq += __shfl_xor(sq, 16); sq += __shfl_xor(sq, 32);
                if (fq == 0) SSQ[(size_t)(row0 + ai * HALF + m * 16) * 16 + u.pn * 4 + wc] = sq; }
            asm volatile("" ::: "memory");
        }
    }
    __device__ __forceinline__ void mid(f32x4 (&)[2][2][4][2], const Unit&, int, int, int, int) const {}
};
struct EpiAct {
    static constexpr bool PERM = true, HAS_MID = false; static constexpr bool PERM16 = false;
    unsigned char* ACT;
    __device__ __forceinline__ void operator()(const f32x4 (&acc)[2][2][4][2], const Unit& u, int wr, int wc, int fr, int fq) const {
        const int row0 = u.pm * BM + wr * 64 + fr, col0 = u.pn * 128 + wc * 32 + 8 * fq;
#pragma unroll
        for (int ai = 0; ai < 2; ++ai)
#pragma unroll
            for (int m = 0; m < 4; ++m) { float a[8];
#pragma unroll
                for (int n = 0; n < 2; ++n)
#pragma unroll
                    for (int j = 0; j < 4; ++j) { const float gg = acc[ai][0][m][n][j] * 0.03125f, uu = acc[ai][1][m][n][j] * 0.03125f; a[4 * n + j] = gg * __builtin_amdgcn_rcpf(1.f + __expf(-gg)) * uu; }
                unsigned w0 = __builtin_amdgcn_cvt_pk_fp8_f32(a[0], a[1], 0, false); w0 = __builtin_amdgcn_cvt_pk_fp8_f32(a[2], a[3], w0, true);
                unsigned w1 = __builtin_amdgcn_cvt_pk_fp8_f32(a[4], a[5], 0, false); w1 = __builtin_amdgcn_cvt_pk_fp8_f32(a[6], a[7], w1, true);
                typedef unsigned u32x2 __attribute__((ext_vector_type(2)));
                *(u32x2*)(ACT + (size_t)(row0 + ai * HALF + m * 16) * DFF + col0) = (u32x2){w0, w1}; }
    }
    __device__ __forceinline__ void mid(f32x4 (&)[2][2][4][2], const Unit&, int, int, int, int) const {}
};
struct EpiDown {
    static constexpr bool PERM = true, HAS_MID = false; static constexpr bool PERM16 = true;
    const int* list; const float* lw; const PG8_LAS int* tab; bf16_t* Y;
    __device__ __forceinline__ void operator()(const f32x4 (&acc)[2][2][4][2], const Unit& u, int wr, int wc, int fr, int fq) const {
        const int cnt = __builtin_amdgcn_readfirstlane(tab[32 + u.e]), col0 = u.pn * BM + wc * 64 + 16 * fq;
        int ent[8]; float wt[8];
#pragma unroll
        for (int q = 0; q < 8; ++q) { const int pos = u.row0 + (q >> 2) * HALF + wr * 64 + (q & 3) * 16 + fr; const bool ok = pos < cnt;
            ent[q] = ok ? list[u.e * NTOK + pos] : -1; wt[q] = ok ? lw[u.e * NTOK + pos] : 0.f; }
        asm volatile("" ::: "memory");
#pragma unroll
        for (int ai = 0; ai < 2; ++ai)
#pragma unroll
            for (int m = 0; m < 4; ++m) { const int e_ = ent[ai * 4 + m]; const float w = wt[ai * 4 + m];
                if (e_ >= 0) {
                    unsigned char* dst = (unsigned char*)Y + ((size_t)(e_ & 1) * NTOK + (size_t)(e_ >> 1)) * D + col0;
                    unsigned wq[4];
#pragma unroll
                    for (int bj = 0; bj < 2; ++bj) { const f32x4 v0 = acc[ai][bj][m][0] * w, v1 = acc[ai][bj][m][1] * w;
                        unsigned w0 = __builtin_amdgcn_cvt_pk_fp8_f32(v0[0], v0[1], 0, false); w0 = __builtin_amdgcn_cvt_pk_fp8_f32(v0[2], v0[3], w0, true);
                        unsigned w1 = __builtin_amdgcn_cvt_pk_fp8_f32(v1[0], v1[1], 0, false); w1 = __builtin_amdgcn_cvt_pk_fp8_f32(v1[2], v1[3], w1, true);
                        wq[2 * bj] = w0; wq[2 * bj + 1] = w1; }
                    *(u32x4*)dst = (u32x4){wq[0], wq[1], wq[2], wq[3]}; }
                if (m & 1) asm volatile("" ::: "memory"); }
    }
    __device__ __forceinline__ void mid(f32x4 (&)[2][2][4][2], const Unit&, int, int, int, int) const {}
};

template <class Epi, class Sched, bool ALIGN_EPI, bool GATHER, bool FP8 = false>
__device__ __forceinline__ void gemm_phase(PG8_LAS unsigned char* lds, const Gemm g, const Sched& S, const Epi& E, const PG8_LAS int* gtab, const int tid) {
    const int wid = __builtin_amdgcn_readfirstlane(tid >> 6), lane = tid & 63, wr = wid >> 2, wc = wid & 3, fr = lane & 15, fq = lane >> 4;
    const int K = g.K, nt = K / BK;
    unsigned vA[2][2], voffB[2];
#pragma unroll
    for (int i = 0; i < 2; ++i) { int R, C; stage_rc(tid * 16 + i * 8192, R, C); const int Rb = Epi::PERM16 ? (64 * (R >> 5) + 16 * ((R >> 2) & 3) + 4 * ((R >> 4) & 1) + (R & 3)) : Epi::PERM ? ((R & ~31) + perm32(R & 31)) : R;
        voffB[i] = (unsigned)(Rb * g.ldb + C) * 2u; vA[0][i] = (unsigned)(R * g.lda + C) * 2u; vA[1][i] = (unsigned)((R + HALF) * g.lda + C) * 2u; }
    const size_t kstep = (size_t)(BK * 2);
    const size_t hstepB = (size_t)(Epi::PERM16 ? 8 : HALF) * g.ldb * 2;
    const unsigned ldsw = (unsigned)wid * 1024u;
    const int aoff = lds_byte(wr * 64 + fr, fq * 8), boff = lds_byte(wc * 32 + fr, fq * 8);
    const int aoff0 = lds_byte(wr * 64 + fr, fq * 16), boff0 = lds_byte(wc * 32 + fr, fq * 16);
#define PG8_SA(b, h) (((b) * 2 + (h)) * HTB)
#define PG8_SB(b, h) ((4 + (b) * 2 + (h)) * HTB)
#define PG8_STAGE2(bufoff, gbase, o0, o1) do { unsigned o0_ = (o0), o1_ = (o1); if constexpr (FP8) asm volatile("" : "+v"(o0_), "+v"(o1_));     \
        __builtin_amdgcn_global_load_lds((const unsigned*)((const char*)(gbase) + o0_), (PG8_LAS unsigned*)(lds + (bufoff) + ldsw), 16, 0, 0); \
        __builtin_amdgcn_global_load_lds((const unsigned*)((const char*)(gbase) + o1_), (PG8_LAS unsigned*)(lds + (bufoff) + ldsw + 8192), 16, 0, 0); } while (0)
#define PG8_STAGE_B(bufoff, gbase) PG8_STAGE2(bufoff, gbase, voffB[0], voffB[1])
#define PG8_STAGE_A(bufoff, gbase, h) PG8_STAGE2(bufoff, gbase, vA[h][0], vA[h][1])
#define PG8_STAGE_AX(bufoff, gbase, h) PG8_STAGE2(bufoff, gbase, vA[h][0], vA[h][1])
#define PG8_LDA8(dst, b, h) do { _Pragma("unroll") for (int m = 0; m < 4; ++m) { const v4i32 c0_ = *(const PG8_LAS v4i32*)(lds + PG8_SA(b, h) + aoff0 + m * 2048), c1_ = *(const PG8_LAS v4i32*)(lds + PG8_SA(b, h) + aoff0 + m * 2048 + 16); \
        dst[m] = __builtin_shufflevector(c0_, c1_, 0, 1, 2, 3, 4, 5, 6, 7); } } while (0)
#define PG8_LDB8(dst, b, h) do { _Pragma("unroll") for (int n = 0; n < 2; ++n) { const v4i32 c0_ = *(const PG8_LAS v4i32*)(lds + PG8_SB(b, h) + boff0 + n * 2048), c1_ = *(const PG8_LAS v4i32*)(lds + PG8_SB(b, h) + boff0 + n * 2048 + 16); \
        dst[n] = __builtin_shufflevector(c0_, c1_, 0, 1, 2, 3, 4, 5, 6, 7); } } while (0)
#define PG8_MMA8(ai, bj, At, Bt) do { __builtin_amdgcn_s_setprio(1); _Pragma("unroll") for (int m = 0; m < 4; ++m) _Pragma("unroll") for (int n = 0; n < 2; ++n) \
        acc[ai][bj][m][n] = __builtin_amdgcn_mfma_scale_f32_16x16x128_f8f6f4(Bt[n], At[m], acc[ai][bj][m][n], 0, 0, 0, 127, 0, 127); __builtin_amdgcn_s_setprio(0); } while (0)
#define PG8_LDA(dst, b, h) do { _Pragma("unroll") for (int m = 0; m < 4; ++m) _Pragma("unroll") for (int k = 0; k < 2; ++k) dst[m][k] = *(const PG8_LAS bf16x8*)(lds + PG8_SA(b, h) + aoff + m * 2048 + k * 1024); } while (0)
#define PG8_LDB(dst, b, h) do { _Pragma("unroll") for (int n = 0; n < 2; ++n) _Pragma("unroll") for (int k = 0; k < 2; ++k) dst[n][k] = *(const PG8_LAS bf16x8*)(lds + PG8_SB(b, h) + boff + n * 2048 + k * 1024); } while (0)
#define PG8_MMA(ai, bj, At, Bt) do { __builtin_amdgcn_s_setprio(1); _Pragma("unroll") for (int m = 0; m < 4; ++m) _Pragma("unroll") for (int n = 0; n < 2; ++n) _Pragma("unroll") for (int k = 0; k < 2; ++k) \
        acc[ai][bj][m][n] = __builtin_amdgcn_mfma_f32_16x16x32_bf16(Bt[n][k], At[m][k], acc[ai][bj][m][n], 0, 0, 0); __builtin_amdgcn_s_setprio(0); } while (0)
#define PG8_WAIT_V(n) asm volatile("s_waitcnt vmcnt(" #n ")" ::: "memory")
#define PG8_WAIT_L(n) asm volatile("s_waitcnt lgkmcnt(" #n ")" ::: "memory")
#define PG8_BAR __builtin_amdgcn_s_barrier()
#define PG8_SCHED __builtin_amdgcn_sched_barrier(0)
    Unit cur, nxt; int ui = 0;
    if (!S.next(0, cur)) return;
    if constexpr (GATHER) {
#pragma unroll
        for (int h = 0; h < 2; ++h)
#pragma unroll
            for (int i = 0; i < 2; ++i) { int R, C; stage_rc(tid * 16 + i * 8192, R, C); vA[h][i] = (unsigned)gtab[R + h * HALF] * (unsigned)(g.lda * 2) + (unsigned)C * 2u; }
    }
    f32x4 acc[2][2][4][2];
#pragma unroll
    for (int a = 0; a < 2; ++a)
#pragma unroll
        for (int b = 0; b < 2; ++b)
#pragma unroll
            for (int m = 0; m < 4; ++m)
#pragma unroll
                for (int n = 0; n < 2; ++n) acc[a][b][m][n] = (f32x4){0.f, 0.f, 0.f, 0.f};
    bf16x8 At[4][2], B0[2][2], B1[2][2]; v8i32 At8[4], B08[2], B18[2];
    const char* cA = S.abase(g, cur); const char* cB = S.bbase(g, cur);
    PG8_STAGE_B(PG8_SB(0, 0), cB); PG8_STAGE_B(PG8_SB(0, 1), cB + hstepB); PG8_STAGE_A(PG8_SA(0, 0), cA, 0); PG8_STAGE_A(PG8_SA(0, 1), cA, 1);
    if (wr == 1) PG8_BAR;
    PG8_WAIT_V(2); PG8_BAR;
    PG8_STAGE_B(PG8_SB(1, 0), cB + kstep); PG8_STAGE_A(PG8_SA(1, 0), cA + kstep, 0); PG8_STAGE_B(PG8_SB(1, 1), cB + hstepB + kstep);
    PG8_WAIT_V(6); PG8_BAR;
    for (;;) {
        const bool has_next = S.next(ui + 1, nxt);
        const char* nA = has_next ? S.abase(g, nxt) : cA; const char* nB = has_next ? S.bbase(g, nxt) : cB;
        _Pragma("nounroll") for (int t = 0; t < nt; t += 2) {
            const bool last = (t == nt - 2);
            if constexpr (Epi::HAS_MID) { if (t == (nt >> 1)) { int ln_e; asm volatile("v_mbcnt_lo_u32_b32 %0, -1, 0\n\tv_mbcnt_hi_u32_b32 %0, -1, %0" : "=v"(ln_e)); E.mid(acc, cur, wr, wc, ln_e & 15, ln_e >> 4); } }
            const char* a1 = cA + (size_t)(t + 1) * kstep;
            const char* a2 = last ? nA : cA + (size_t)(t + 2) * kstep; const char* b2 = last ? nB : cB + (size_t)(t + 2) * kstep;
            const char* a3 = a2 + kstep; const char* b3 = b2 + kstep;

            if constexpr (FP8) { PG8_LDB8(B08, 0, 0); PG8_LDB8(B18, 0, 1); PG8_SCHED; PG8_LDA8(At8, 0, 0); } else { PG8_LDB(B0, 0, 0); PG8_LDB(B1, 0, 1); PG8_SCHED; PG8_LDA(At, 0, 0); } PG8_STAGE_A(PG8_SA(1, 1), a1, 1);
            if constexpr (GATHER) { if (last && has_next) {
#pragma unroll
                for (int h = 0; h < 2; ++h)
#pragma unroll
                    for (int i = 0; i < 2; ++i) { int R, C; stage_rc(tid * 16 + i * 8192, R, C); vA[h][i] = (unsigned)gtab[(ui + 1) * BM + R + h * HALF] * (unsigned)(g.lda * 2) + (unsigned)C * 2u; } } }
            PG8_WAIT_V(8); PG8_WAIT_L(0); PG8_BAR; if constexpr (FP8) { PG8_MMA8(0, 0, At8, B08); PG8_MMA8(0, 1, At8, B18); } else { PG8_MMA(0, 0, At, B0); PG8_MMA(0, 1, At, B1); } PG8_BAR; PG8_SCHED;
            if constexpr (FP8) { PG8_LDA8(At8, 0, 1); } else { PG8_LDA(At, 0, 1); } PG8_STAGE_B(PG8_SB(0, 0), b2); PG8_STAGE_B(PG8_SB(0, 1), b2 + hstepB); PG8_STAGE_AX(PG8_SA(0, 0), a2, 0);
            PG8_WAIT_V(8); PG8_WAIT_L(0); PG8_BAR; if constexpr (FP8) { PG8_MMA8(1, 0, At8, B08); PG8_MMA8(1, 1, At8, B18); } else { PG8_MMA(1, 0, At, B0); PG8_MMA(1, 1, At, B1); } PG8_BAR; PG8_SCHED;
            if constexpr (FP8) { PG8_LDB8(B08, 1, 0); PG8_LDB8(B18, 1, 1); PG8_SCHED; PG8_LDA8(At8, 1, 0); } else { PG8_LDB(B0, 1, 0); PG8_LDB(B1, 1, 1); PG8_SCHED; PG8_LDA(At, 1, 0); } PG8_STAGE_AX(PG8_SA(0, 1), a2, 1);
            PG8_WAIT_V(8); PG8_WAIT_L(0); PG8_BAR; if constexpr (FP8) { PG8_MMA8(0, 0, At8, B08); PG8_MMA8(0, 1, At8, B18); } else { PG8_MMA(0, 0, At, B0); PG8_MMA(0, 1, At, B1); } PG8_BAR; PG8_SCHED;
            if constexpr (FP8) { PG8_LDA8(At8, 1, 1); } else { PG8_LDA(At, 1, 1); } PG8_STAGE_B(PG8_SB(1, 0), b3); PG8_STAGE_B(PG8_SB(1, 1), b3 + hstepB); PG8_STAGE_AX(PG8_SA(1, 0), a3, 0);
            PG8_WAIT_V(8); PG8_WAIT_L(0); PG8_BAR; if constexpr (FP8) { PG8_MMA8(1, 0, At8, B08); PG8_MMA8(1, 1, At8, B18); } else { PG8_MMA(1, 0, At, B0); PG8_MMA(1, 1, At, B1); } PG8_BAR; PG8_SCHED;
        }
        if constexpr (ALIGN_EPI) { if (wr == 0) PG8_BAR; }
        { int ln_e; asm volatile("v_mbcnt_lo_u32_b32 %0, -1, 0\n\tv_mbcnt_hi_u32_b32 %0, -1, %0" : "=v"(ln_e)); E(acc, cur, wr, wc, ln_e & 15, ln_e >> 4); }
        if (!has_next) break;
#pragma unroll
        for (int a = 0; a < 2; ++a)
#pragma unroll
            for (int b = 0; b < 2; ++b)
#pragma unroll
                for (int m = 0; m < 4; ++m)
#pragma unroll
                    for (int n = 0; n < 2; ++n) acc[a][b][m][n] = (f32x4){0.f, 0.f, 0.f, 0.f};
        cur = nxt; cA = nA; cB = nB; ++ui;
        if constexpr (ALIGN_EPI) { if (wr == 1) PG8_BAR; }
    }
    PG8_WAIT_V(0);
    if constexpr (!ALIGN_EPI) { if (wr == 0) PG8_BAR; }
    PG8_BAR;
#undef PG8_SA
#undef PG8_SB
#undef PG8_STAGE2
#undef PG8_STAGE_A
#undef PG8_STAGE_AX
#undef PG8_STAGE_B
#undef PG8_LDA
#undef PG8_LDA8
#undef PG8_LDB8
#undef PG8_MMA8
#undef PG8_LDB
#undef PG8_MMA
#undef PG8_WAIT_V
#undef PG8_WAIT_L
#undef PG8_BAR
#undef PG8_SCHED
}
}

#define XB_TMO      128
#define XB_XCNT(j)  (256  + 64 * (j))
#define XB_XSUB(j)  (1280 + 64 * (j))
#define XB_XGEN(j)  (2304 + 64 * (j))
#define XB_TOP      3328
#define XB_TOPGEN   3392
#define XCD_BAR_WORDS 3456
#define XB_SPIN_CAP (1u << 18)

__device__ __forceinline__ unsigned xb_ld(unsigned* p)              { return __hip_atomic_load(p, __ATOMIC_RELAXED, __HIP_MEMORY_SCOPE_AGENT); }
__device__ __forceinline__ unsigned xb_add(unsigned* p, unsigned v) { return __hip_atomic_fetch_add(p, v, __ATOMIC_RELAXED, __HIP_MEMORY_SCOPE_AGENT); }
__device__ __forceinline__ unsigned xb_xcc_id() { return (unsigned)__builtin_amdgcn_s_getreg((3 << 11) | 20) & 0xFu; }
#define XB_SPIN(cond, bar) do { unsigned _sp = 0; while (cond) { __builtin_amdgcn_s_sleep(1); \
    if ((++_sp & 255u) == 0u) { if (xb_ld(&(bar)[XB_TMO])) break; if (_sp > XB_SPIN_CAP) { atomicAdd(&(bar)[XB_TMO], 1u); break; } } } } while (0)

struct XcdBarrier { unsigned* bar; unsigned x; volatile LAS unsigned* st; };

__device__ __forceinline__ XcdBarrier xcd_barrier_post(unsigned* bar, volatile LAS unsigned* st, int tid_) {
    XcdBarrier b; b.bar = bar; b.x = xb_xcc_id(); b.st = st;
    if (tid_ == 0) (void)xb_add(&bar[XB_XCNT(b.x)], 1u);
    return b;
}
__device__ __forceinline__ void xcd_barrier_complete(unsigned* bar, unsigned x, unsigned& nloc, unsigned& nx) {
    const unsigned G = gridDim.x * gridDim.y * gridDim.z;
    unsigned sum, cnt, mine, sp = 0u;
    for (;;) {
        sum = 0u; cnt = 0u; mine = 0u;
#pragma unroll
        for (unsigned j = 0; j < 16; ++j) { const unsigned c = xb_ld(&bar[XB_XCNT(j)]); sum += c; cnt += (c > 0u) ? 1u : 0u; mine = (j == x) ? c : mine; }
        if (sum == G) break;
        __builtin_amdgcn_s_sleep(1);
        if ((++sp & 255u) == 0u) { if (xb_ld(&bar[XB_TMO])) break; if (sp > XB_SPIN_CAP) { atomicAdd(&bar[XB_TMO], 1u); break; } }
    }
    nloc = mine > 0u ? mine : 1u; nx = cnt > 0u ? cnt : 1u;
}
__device__ __forceinline__ void xcd_barrier(const XcdBarrier& b, int tid_, const unsigned char* warm = nullptr, LAS unsigned char* junk = nullptr) {
    asm volatile("s_waitcnt vmcnt(0)" ::: "memory");
    __syncthreads();
    if (warm != nullptr && (tid_ >> 6) == 7) { const int l_ = tid_ & 63; if (l_ < 38) __builtin_amdgcn_global_load_lds((const unsigned*)(warm + l_ * 128), (LAS unsigned*)junk, 4, 0, 0); }
    if (tid_ == 0) {
        unsigned* bar = b.bar;
        __builtin_amdgcn_s_waitcnt(0);
        unsigned nloc = b.st[0], nx = b.st[1];
        if (nloc == 0u) { xcd_barrier_complete(bar, b.x, nloc, nx); b.st[0] = nloc; b.st[1] = nx; }
        const unsigned old = xb_add(&bar[XB_XSUB(b.x)], 1u);
        const unsigned gen = old / nloc;
        if (old + 1u == (gen + 1u) * nloc) {
            __builtin_amdgcn_fence(__ATOMIC_RELEASE, "agent");
            asm volatile("s_waitcnt vmcnt(0)" ::: "memory");
            const unsigned og = xb_add(&bar[XB_TOP], 1u);
            const unsigned tg = og / nx;
            if (og + 1u == (tg + 1u) * nx) xb_add(&bar[XB_TOPGEN], 1u);
            else XB_SPIN(xb_ld(&bar[XB_TOPGEN]) == tg, bar);
            __builtin_amdgcn_fence(__ATOMIC_ACQUIRE, "agent");
            xb_add(&bar[XB_XGEN(b.x)], 1u);
            asm volatile("s_waitcnt vmcnt(0)" ::: "memory");
        } else {
            XB_SPIN(xb_ld(&bar[XB_XGEN(b.x)]) == gen, bar);
            __builtin_amdgcn_fence(__ATOMIC_ACQUIRE, "agent");
            asm volatile("s_waitcnt vmcnt(0)" ::: "memory");
        }
    }
    __syncthreads();
}


namespace att {
typedef float f32x16 __attribute__((ext_vector_type(16)));
typedef short v4i16_t __attribute__((ext_vector_type(4)));
constexpr float ATT_THR = 16.f;
__device__ __forceinline__ int crow(int r, int hi) { return (r & 3) + 8 * (r >> 2) + 4 * hi; }
__device__ __forceinline__ unsigned cvtpk(float lo, float hi) { typedef float f2 __attribute__((ext_vector_type(2))); typedef __bf16 b2 __attribute__((ext_vector_type(2))); f2 v = {lo, hi}; b2 b = __builtin_convertvector(v, b2); return __builtin_bit_cast(unsigned, b); }
__device__ __forceinline__ bf16x8 pack8(const f32x16& p, int b0) { v4u w; w.x = cvtpk(p[b0], p[b0 + 1]); w.y = cvtpk(p[b0 + 2], p[b0 + 3]); w.z = cvtpk(p[b0 + 4], p[b0 + 5]); w.w = cvtpk(p[b0 + 6], p[b0 + 7]); return __builtin_bit_cast(bf16x8, w); }

__device__ __forceinline__ void glds16(const void* gsrc, unsigned lds_dst) { unsigned keep;
    asm volatile("s_mov_b32 %0, m0\n\ts_mov_b32 m0, %2\n\ts_nop 0\n\tglobal_load_lds_dwordx4 %1, off\n\ts_mov_b32 m0, %0" : "=&s"(keep) : "v"(gsrc), "s"(lds_dst) : "memory"); }
template <bool SB>
__device__ __forceinline__ void attn_wave(int b, int hc, int q0, const bf16* Q, const bf16* K, const bf16* V, bf16* O, const float* Frow, float bk2, LAS unsigned char* vlds, int lane) {
    const int r32 = lane & 31, hi = lane >> 5;
    const size_t rowb = (size_t)b * SEQ;
    const bf16* Kh = K + rowb * D + hc; const bf16* Vh = V + rowb * D + hc;
    bf16x8 qr[4];
#pragma unroll
    for (int d0 = 0; d0 < 4; ++d0) qr[d0] = *(const bf16x8*)(Q + (rowb + q0 + r32) * D + hc + 16 * d0 + 8 * hi);
    const bf16* ksrc = Kh + (size_t)r32 * D + 8 * hi;
    const bf16* vsrc = Vh + (size_t)(lane >> 2) * D + (lane & 3) * 8;
    LAS unsigned char* vw = vlds + lane * 16;
    LAS unsigned char* vrd = vlds + ((lane >> 4) & 1) * 32 + (lane & 3) * 8 + (4 * hi + ((lane & 15) >> 2)) * 64;
    const int td = q0 >> 6, qabs = q0 + r32;
    float carry = 0.f; bf16x8 T0, T1;
    if constexpr (SB) {
        v4u a, c;
#pragma unroll
        for (int w = 0; w < 4; ++w) { unsigned lo, hi2;
            { const int jj = 2 * w; const int j0 = 8 * (jj >> 2) + 4 * hi + (jj & 3), j1 = j0 + 1;
              lo = ((j0 > r32) ? 0x3F80u : 0u) | ((j1 > r32) ? 0x3F800000u : 0u); hi2 = ((16 + j0 > r32) ? 0x3F80u : 0u) | ((16 + j1 > r32) ? 0x3F800000u : 0u); }
            a[w] = lo; c[w] = hi2; }
        T0 = __builtin_bit_cast(bf16x8, a); T1 = __builtin_bit_cast(bf16x8, c);
    }
    bf16x8 kf[8]; v4u vst[8];
#define ATT_LOADK(t_) do { _Pragma("unroll") for (int d0 = 0; d0 < 4; ++d0) { kf[2 * d0] = *(const bf16x8*)(ksrc + (size_t)((t_) * 64) * D + 16 * d0); kf[2 * d0 + 1] = *(const bf16x8*)(ksrc + (size_t)((t_) * 64 + 32) * D + 16 * d0); } } while (0)
#define ATT_LOADV(t_) do { _Pragma("unroll") for (int p = 0; p < 8; ++p) vst[p] = *(const v4u*)(vsrc + (size_t)((t_) * 64 + 16 * (p & 3)) * D + 32 * (p >> 2)); } while (0)
#define ATT_WRITEV(sl_) do { _Pragma("unroll") for (int p = 0; p < 8; ++p) *(LAS v4u*)(vw + (sl_) * 8192 + p * 1024) = vst[p]; } while (0)
    int t = td; constexpr int slot = 0;
    LAS float* fwin = (LAS float*)(vlds + 8192);
    const int tw0 = (td > 31) ? td - 31 : 0, wk0 = tw0 * 64;
    ATT_LOADK(t); ATT_LOADV(t);
    if constexpr (!SB) {
        f32x4 fw[8];
#pragma unroll
        for (int i = 0; i < 8; ++i) { const int key = wk0 + 4 * lane + 256 * i; fw[i] = (key < td * 64 + 64) ? *(const f32x4*)(Frow + key) : (f32x4){0.f, 0.f, 0.f, 0.f}; }
#pragma unroll
        for (int i = 0; i < 8; ++i) *(LAS f32x4*)(fwin + 4 * lane + 256 * i) = fw[i];
    }
    ATT_WRITEV(0);
    f32x16 o[2];
#pragma unroll
    for (int r = 0; r < 16; ++r) { o[0][r] = 0.f; o[1][r] = 0.f; }
    float m = -INFINITY, l = 0.f, FrL = 0.f, bqbk = 0.f;
    if constexpr (!SB) {
        FrL = Frow[q0] * LOG2E;
        float qs = 0.f;
#pragma unroll
        for (int d0 = 0; d0 < 4; ++d0) { const v4u w = __builtin_bit_cast(v4u, qr[d0]);
#pragma unroll
            for (int e = 0; e < 4; ++e) { const float x0 = bflo(w[e]), x1 = bfhi(w[e]); qs += x0 * x0 + x1 * x1; } }
        qs += __shfl_xor(qs, 32);
#pragma unroll
        for (int off = 1; off < 32; off <<= 1) qs = fmaxf(qs, __shfl_xor(qs, off));
        bqbk = sqrtf(qs * bk2) * 1.02f + 0.01f;
    }
    for (;;) {
        const int kv0 = t * 64; const bool more = t > 0, diag = (t == td);
        if constexpr (!SB) { if (more) ATT_LOADV(t - 1); }
        f32x16 p0, p1;
        if constexpr (SB) {
#pragma unroll
            for (int r = 0; r < 16; ++r) { p0[r] = 0.f; p1[r] = 0.f; }
        } else {
#pragma unroll
            for (int g = 0; g < 4; ++g) { f32x4 fa, fb;
                if (t >= tw0) { fa = *(const LAS f32x4*)(fwin + (kv0 - wk0) + 8 * g + 4 * hi); fb = *(const LAS f32x4*)(fwin + (kv0 - wk0) + 32 + 8 * g + 4 * hi); }
                else { fa = *(const f32x4*)(Frow + kv0 + 8 * g + 4 * hi); fb = *(const f32x4*)(Frow + kv0 + 32 + 8 * g + 4 * hi); }
#pragma unroll
                for (int c = 0; c < 4; ++c) { p0[4 * g + c] = __builtin_fmaf(fa[c], -LOG2E, FrL); p1[4 * g + c] = __builtin_fmaf(fb[c], -LOG2E, FrL); } }
        }
#pragma unroll
        for (int d0 = 0; d0 < 4; ++d0) { p0 = __builtin_amdgcn_mfma_f32_32x32x16_bf16(kf[2 * d0], qr[d0], p0, 0, 0, 0); p1 = __builtin_amdgcn_mfma_f32_32x32x16_bf16(kf[2 * d0 + 1], qr[d0], p1, 0, 0, 0); }
        if (more) ATT_LOADK(t - 1);
        bf16x8 pw[4];
        if constexpr (SB) {
            f32x16 lb0, lb1;
            float rt0 = 0.f, rt1 = 0.f;
#pragma unroll
            for (int r = 0; r < 16; ++r) {
                { const float z = p0[r], lg = __builtin_amdgcn_logf(1.f + __builtin_amdgcn_exp2f(-fabsf(z))); const float lbv = fminf(z, 0.f) - lg; float lm = lbv - z;
                  const bool valid = !diag || (kv0 + crow(r, hi) < qabs); lm = valid ? lm : 0.f; lb0[r] = valid ? lbv : -INFINITY; p0[r] = lm; rt0 += lm; }
                { const float z = p1[r], lg = __builtin_amdgcn_logf(1.f + __builtin_amdgcn_exp2f(-fabsf(z))); const float lbv = fminf(z, 0.f) - lg; float lm = lbv - z;
                  const bool valid = !diag || (kv0 + 32 + crow(r, hi) < qabs); lm = valid ? lm : 0.f; lb1[r] = valid ? lbv : -INFINITY; p1[r] = lm; rt1 += lm; }
            }
            rt0 += __shfl_xor(rt0, 32); rt1 += __shfl_xor(rt1, 32);
            const bf16x8 m0 = pack8(p0, 0), m1 = pack8(p0, 8), m2 = pack8(p1, 0), m3 = pack8(p1, 8);
            { const float c0_ = carry + rt1;
#pragma unroll
              for (int r = 0; r < 16; ++r) { lb0[r] += c0_; lb1[r] += carry; } }
            lb0 = __builtin_amdgcn_mfma_f32_32x32x16_bf16(T0, m0, lb0, 0, 0, 0); lb0 = __builtin_amdgcn_mfma_f32_32x32x16_bf16(T1, m1, lb0, 0, 0, 0);
            lb1 = __builtin_amdgcn_mfma_f32_32x32x16_bf16(T0, m2, lb1, 0, 0, 0); lb1 = __builtin_amdgcn_mfma_f32_32x32x16_bf16(T1, m3, lb1, 0, 0, 0);
#pragma unroll
            for (int r = 0; r < 16; ++r) { p0[r] = __builtin_amdgcn_exp2f(lb0[r]); p1[r] = __builtin_amdgcn_exp2f(lb1[r]); }
            carry += rt0 + rt1;
        } else {
            if (diag) {
#pragma unroll
                for (int r = 0; r < 16; ++r) { if (kv0 + crow(r, hi) > qabs) p0[r] = -INFINITY; if (kv0 + 32 + crow(r, hi) > qabs) p1[r] = -INFINITY; }
            }
            float mx = fmaxf(p0[0], p1[0]);
#pragma unroll
            for (int r = 1; r < 16; ++r) mx = fmaxf(mx, fmaxf(p0[r], p1[r]));
            mx = fmaxf(mx, __shfl_xor(mx, 32));
            const float mnew = fmaxf(m, mx);
            if (__any(mnew > m)) { const float sc = __builtin_amdgcn_exp2f(m - mnew); l *= sc;
#pragma unroll
                for (int r = 0; r < 16; ++r) { o[0][r] *= sc; o[1][r] *= sc; }
                m = mnew; }
            float ls = 0.f;
#pragma unroll
            for (int r = 0; r < 16; ++r) { p0[r] = __builtin_amdgcn_exp2f(p0[r] - m); p1[r] = __builtin_amdgcn_exp2f(p1[r] - m); ls += p0[r] + p1[r]; }
            l += ls;
        }
        pw[0] = pack8(p0, 0); pw[1] = pack8(p0, 8); pw[2] = pack8(p1, 0); pw[3] = pack8(p1, 8);
        if constexpr (SB) { if (more) ATT_LOADV(t - 1); }
#pragma unroll
        for (int d0 = 0; d0 < 2; ++d0)
#pragma unroll
            for (int ks = 0; ks < 4; ++ks) {
                const v4i16_t lo = __builtin_amdgcn_ds_read_tr16_b64_v4i16((LAS v4i16_t*)(vrd + slot * 8192 + d0 * 4096 + ks * 1024));
                const v4i16_t hh = __builtin_amdgcn_ds_read_tr16_b64_v4i16((LAS v4i16_t*)(vrd + slot * 8192 + d0 * 4096 + ks * 1024 + 512));
                const bf16x8 vf = (bf16x8){lo[0], lo[1], lo[2], lo[3], hh[0], hh[1], hh[2], hh[3]};
                o[d0] = __builtin_amdgcn_mfma_f32_32x32x16_bf16(vf, pw[ks], o[d0], 0, 0, 0);
            }
        if (!more) break;
        if constexpr (SB) { if (__all(carry < -ATT_THR)) break; }
        else { const float fe = (t > tw0) ? fwin[kv0 - 1 - wk0] : Frow[kv0 - 1]; const float ub = bqbk + __builtin_fmaf(fe, -LOG2E, FrL); if (__all(ub < m - ATT_THR)) break; }
        ATT_WRITEV(0); --t;
    }
#undef ATT_LOADK
#undef ATT_LOADV
#undef ATT_WRITEV
    float inv = 1.f;
    if constexpr (!SB) { l += __shfl_xor(l, 32); inv = 1.f / l; }
    bf16* op = O + (rowb + q0 + r32) * D + hc + 4 * hi;
#pragma unroll
    for (int d0 = 0; d0 < 2; ++d0)
#pragma unroll
        for (int g = 0; g < 4; ++g) { v2u w; w.x = cvtpk(o[d0][4 * g] * inv, o[d0][4 * g + 1] * inv); w.y = cvtpk(o[d0][4 * g + 2] * inv, o[d0][4 * g + 3] * inv); *(v2u*)(op + 32 * d0 + 8 * g) = w; }
}

template <int SL>
__device__ __forceinline__ void attu_fox(int kv0, bool diag, int qabs, int hi, int lane, const bf16x8 (&qr)[4], float FrL, LAS unsigned char* Kring, LAS unsigned char* vrd, const LAS float* fwin,
                                         f32x16 (&o)[2], float& mref, float& mxrun, float& l) {
    bf16x8 kf[8];
#pragma unroll
    for (int p = 0; p < 8; ++p) kf[p] = *(const LAS bf16x8*)(Kring + SL * 8192 + p * 1024 + lane * 16);
    f32x16 p0, p1; const float cm = FrL - mref;
#pragma unroll
    for (int g = 0; g < 4; ++g) { const f32x4 fa = *(const LAS f32x4*)(fwin + kv0 + 8 * g + 4 * hi), fb = *(const LAS f32x4*)(fwin + kv0 + 32 + 8 * g + 4 * hi);
#pragma unroll
        for (int c = 0; c < 4; ++c) { p0[4 * g + c] = fa[c] + cm; p1[4 * g + c] = fb[c] + cm; } }
#pragma unroll
    for (int d0 = 0; d0 < 4; ++d0) { p0 = __builtin_amdgcn_mfma_f32_32x32x16_bf16(kf[2 * d0], qr[d0], p0, 0, 0, 0); p1 = __builtin_amdgcn_mfma_f32_32x32x16_bf16(kf[2 * d0 + 1], qr[d0], p1, 0, 0, 0); }
    if (diag) {
#pragma unroll
        for (int r = 0; r < 16; ++r) { if (kv0 + crow(r, hi) > qabs) p0[r] = -INFINITY; if (kv0 + 32 + crow(r, hi) > qabs) p1[r] = -INFINITY; }
    }
    float ma = fmaxf(fmaxf(p0[0], p0[1]), p0[2]), mb = fmaxf(fmaxf(p1[0], p1[1]), p1[2]);
#pragma unroll
    for (int r = 3; r < 15; r += 2) { ma = fmaxf(fmaxf(ma, p0[r]), p0[r + 1]); mb = fmaxf(fmaxf(mb, p1[r]), p1[r + 1]); }
    float mx = fmaxf(fmaxf(ma, mb), fmaxf(p0[15], p1[15]));
    mx = fmaxf(mx, __shfl_xor(mx, 32));
    mxrun = fmaxf(mxrun, mx);
    if (__any(mx > 0.f)) {
        const float dl = fmaxf(mx, 0.f), sc = __builtin_amdgcn_exp2f(-dl); mref += dl; mxrun -= dl; l *= sc;
#pragma unroll
        for (int r = 0; r < 16; ++r) { p0[r] -= dl; p1[r] -= dl; o[0][r] *= sc; o[1][r] *= sc; }
    }
    float ls0 = 0.f, ls1 = 0.f;
#pragma unroll
    for (int r = 0; r < 16; ++r) { p0[r] = __builtin_amdgcn_exp2f(p0[r]); p1[r] = __builtin_amdgcn_exp2f(p1[r]); ls0 += p0[r]; ls1 += p1[r]; }
    l += ls0 + ls1;
    bf16x8 pw[4];
    pw[0] = pack8(p0, 0); pw[1] = pack8(p0, 8); pw[2] = pack8(p1, 0); pw[3] = pack8(p1, 8);
#pragma unroll
    for (int d0 = 0; d0 < 2; ++d0)
#pragma unroll
        for (int ks = 0; ks < 4; ++ks) {
            const v4i16_t lo = __builtin_amdgcn_ds_read_tr16_b64_v4i16((LAS v4i16_t*)(vrd + SL * 8192 + d0 * 4096 + ks * 1024));
            const v4i16_t hh = __builtin_amdgcn_ds_read_tr16_b64_v4i16((LAS v4i16_t*)(vrd + SL * 8192 + d0 * 4096 + ks * 1024 + 512));
            const bf16x8 vf = (bf16x8){lo[0], lo[1], lo[2], lo[3], hh[0], hh[1], hh[2], hh[3]};
            o[d0] = __builtin_amdgcn_mfma_f32_32x32x16_bf16(vf, pw[ks], o[d0], 0, 0, 0);
        }
}
template <int SL>
__device__ __forceinline__ void attu_sb(int kv0, bool diag, int qabs, int q0, int hi, int lane, const bf16x8 (&qr)[4], const bf16x8 T0, const bf16x8 T1, LAS unsigned char* Kring, LAS unsigned char* vrd,
                                        f32x16 (&o)[2], float& carry) {
    const bool skip1 = diag && !(q0 & 32);
    bf16x8 pw[4]; float rt1 = 0.f, rt0 = 0.f;
    pw[2] = (bf16x8){0, 0, 0, 0, 0, 0, 0, 0}; pw[3] = pw[2];
#define ATTU_SBBLK(BLK, RT, CADD, PWA, PWB) do { f32x16 pb, lbb; \
        _Pragma("unroll") for (int r = 0; r < 16; ++r) pb[r] = 0.f; \
        _Pragma("unroll") for (int d0 = 0; d0 < 4; ++d0) { const bf16x8 kq = *(const LAS bf16x8*)(Kring + SL * 8192 + (2 * d0 + BLK) * 1024 + lane * 16); pb = __builtin_amdgcn_mfma_f32_32x32x16_bf16(kq, qr[d0], pb, 0, 0, 0); } \
        if (diag) { _Pragma("unroll") for (int r = 0; r < 16; ++r) { const float z = pb[r], lg = __builtin_amdgcn_logf(1.f + __builtin_amdgcn_exp2f(-fabsf(z))); const float lbv = fminf(z, 0.f) - lg; float lm = lbv - z; \
                const bool valid = (kv0 + 32 * BLK + crow(r, hi) < qabs); lm = valid ? lm : 0.f; lbb[r] = valid ? lbv : -INFINITY; pb[r] = lm; RT += lm; } } \
        else { _Pragma("unroll") for (int r = 0; r < 16; ++r) { const float z = pb[r], lg = __builtin_amdgcn_logf(1.f + __builtin_amdgcn_exp2f(-fabsf(z))); const float lbv = fminf(z, 0.f) - lg; const float lm = lbv - z; lbb[r] = lbv; pb[r] = lm; RT += lm; } } \
        RT += __shfl_xor(RT, 32); \
        { const bf16x8 ma = pack8(pb, 0), mb = pack8(pb, 8); const float ca_ = (CADD); \
          _Pragma("unroll") for (int r = 0; r < 16; ++r) lbb[r] += ca_; \
          lbb = __builtin_amdgcn_mfma_f32_32x32x16_bf16(T0, ma, lbb, 0, 0, 0); lbb = __builtin_amdgcn_mfma_f32_32x32x16_bf16(T1, mb, lbb, 0, 0, 0); } \
        _Pragma("unroll") for (int r = 0; r < 16; ++r) pb[r] = __builtin_amdgcn_exp2f(lbb[r]); \
        PWA = pack8(pb, 0); PWB = pack8(pb, 8); } while (0)
    if (!skip1) ATTU_SBBLK(1, rt1, carry, pw[2], pw[3]);
    ATTU_SBBLK(0, rt0, carry + rt1, pw[0], pw[1]);
#undef ATTU_SBBLK
    carry += rt0 + rt1;
#pragma unroll
    for (int d0 = 0; d0 < 2; ++d0)
#pragma unroll
        for (int ks = 0; ks < 4; ++ks) { if (ks >= 2 && skip1) continue;
            const v4i16_t lo = __builtin_amdgcn_ds_read_tr16_b64_v4i16((LAS v4i16_t*)(vrd + SL * 8192 + d0 * 4096 + ks * 1024));
            const v4i16_t hh = __builtin_amdgcn_ds_read_tr16_b64_v4i16((LAS v4i16_t*)(vrd + SL * 8192 + d0 * 4096 + ks * 1024 + 512));
            const bf16x8 vf = (bf16x8){lo[0], lo[1], lo[2], lo[3], hh[0], hh[1], hh[2], hh[3]};
            o[d0] = __builtin_amdgcn_mfma_f32_32x32x16_bf16(vf, pw[ks], o[d0], 0, 0, 0);
        }
}
template <bool SB>
__device__ __forceinline__ void attn_unit(int b, int hc, int q0u, const bf16* Q, const bf16* K, const bf16* V, bf16* O, const float* Frow, float bk2, LAS unsigned char* lds, LAS unsigned char* flagb, int wave, int lane_, bool domath = true) {
    int lane = lane_; asm volatile("" : "+v"(lane));
    const int r32 = lane & 31, hi = lane >> 5, half = wave >> 2, hw = wave & 3;
    const size_t rowb = (size_t)b * SEQ;
    const bf16* Kh = K + rowb * D + hc; const bf16* Vh = V + rowb * D + hc;
    const int q0h = q0u + 128 * half, q0 = q0h + hw * 32, qabs = q0 + r32;
    const int ttop = (q0h >> 6) + 1, tdw = q0 >> 6;
    LAS unsigned char* Kring = lds + half * 49152; LAS unsigned char* Vring = Kring + 24576;
    LAS float* fwin = (LAS float*)(lds + 98304);
    const unsigned kdst0 = (unsigned)(size_t)(Kring + hw * 1024), vdst0 = (unsigned)(size_t)(Vring + hw * 1024);
    const bf16* ksrc0 = Kh + (size_t)(32 * (hw & 1) + r32) * D + 16 * (hw >> 1) + 8 * hi;
    const bf16* vsrc0 = Vh + (size_t)(16 * hw + (lane >> 2)) * D + 8 * (lane & 3);
#define ATTU_DMA(t_, slot_) do { const int tt_ = (t_) < 0 ? 0 : (t_); \
        glds16(ksrc0 + (size_t)tt_ * 64 * D, (unsigned)__builtin_amdgcn_readfirstlane((int)(kdst0 + (slot_) * 8192))); \
        glds16(ksrc0 + (size_t)tt_ * 64 * D + 32, (unsigned)__builtin_amdgcn_readfirstlane((int)(kdst0 + (slot_) * 8192 + 4096))); \
        glds16(vsrc0 + (size_t)tt_ * 64 * D, (unsigned)__builtin_amdgcn_readfirstlane((int)(vdst0 + (slot_) * 8192))); \
        glds16(vsrc0 + (size_t)tt_ * 64 * D + 32, (unsigned)__builtin_amdgcn_readfirstlane((int)(vdst0 + (slot_) * 8192 + 4096))); } while (0)
    ATTU_DMA(ttop, 0); ATTU_DMA(ttop - 1, 1);
    bf16x8 qr[4];
#pragma unroll
    for (int d0 = 0; d0 < 4; ++d0) qr[d0] = *(const bf16x8*)(Q + (rowb + q0 + r32) * D + hc + 16 * d0 + 8 * hi);
    if constexpr (!SB) {
        const int tid_ = wave * 64 + lane;
#pragma unroll
        for (int i = 0; i < 2; ++i) { const int idx = 4 * tid_ + 2048 * i; if (idx < q0u + 256) *(LAS f32x4*)(fwin + idx) = *(const f32x4*)(Frow + idx) * (-LOG2E); }
    }
    if (lane == 0) { flagb[wave] = 0; flagb[8 + wave] = 0; }
    asm volatile("" : "+v"(qr[0]), "+v"(qr[1]), "+v"(qr[2]), "+v"(qr[3]));
    LAS unsigned char* vrd = Vring + ((lane >> 4) & 1) * 32 + (lane & 3) * 8 + (4 * hi + ((lane & 15) >> 2)) * 64;
    f32x16 o[2];
#pragma unroll
    for (int r = 0; r < 16; ++r) { o[0][r] = 0.f; o[1][r] = 0.f; }
    float mref = 0.f, mxrun = -INFINITY, l = 0.f, FrL = 0.f, bqbk = 0.f, carry = 0.f; bf16x8 T0, T1;
    if constexpr (SB) {
        v4u a, c;
#pragma unroll
        for (int w = 0; w < 4; ++w) { unsigned lo, hi2;
            { const int jj = 2 * w; const int j0 = 8 * (jj >> 2) + 4 * hi + (jj & 3), j1 = j0 + 1;
              lo = ((j0 > r32) ? 0x3F80u : 0u) | ((j1 > r32) ? 0x3F800000u : 0u); hi2 = ((16 + j0 > r32) ? 0x3F80u : 0u) | ((16 + j1 > r32) ? 0x3F800000u : 0u); }
            a[w] = lo; c[w] = hi2; }
        T0 = __builtin_bit_cast(bf16x8, a); T1 = __builtin_bit_cast(bf16x8, c);
    } else {
        T0 = (bf16x8){0, 0, 0, 0, 0, 0, 0, 0}; T1 = T0;
        FrL = Frow[q0] * LOG2E;
        float qs = 0.f;
#pragma unroll
        for (int d0 = 0; d0 < 4; ++d0) { const v4u w = __builtin_bit_cast(v4u, qr[d0]);
#pragma unroll
            for (int e = 0; e < 4; ++e) { const float x0 = bflo(w[e]), x1 = bfhi(w[e]); qs += x0 * x0 + x1 * x1; } }
        qs += __shfl_xor(qs, 32);
#pragma unroll
        for (int off = 1; off < 32; off <<= 1) qs = fmaxf(qs, __shfl_xor(qs, off));
        bqbk = sqrtf(qs * bk2) * 1.02f + 0.01f;
        asm volatile("" : "+v"(FrL), "+v"(bqbk));
    }
    bool fin = false;
    int s = 0;
#define ATTU_STEP(SL) { const int t = ttop - s, kv0 = t * 64; \
          \
        asm volatile("s_waitcnt vmcnt(4) lgkmcnt(0)\n\ts_barrier" ::: "memory"); \
        if (s > 0) { const v2u f2 = *(const LAS v2u*)(flagb + ((s - 1) & 1) * 8); if (__builtin_amdgcn_readfirstlane((int)((f2.x & f2.y) == 0x01010101u))) break; } \
        ATTU_DMA(t - 2, (SL + 2) % 3);     \
        if (!domath) { if (t <= 0) fin = true; }          \
        else if (t <= tdw && t >= 0 && !fin) { \
            if constexpr (SB) { attu_sb<SL>(kv0, t == tdw, qabs, q0, hi, lane, qr, T0, T1, Kring, vrd, o, carry); \
                fin = (t == 0) || __all(carry < -ATT_THR); } \
            else { attu_fox<SL>(kv0, t == tdw, qabs, hi, lane, qr, FrL, Kring, vrd, fwin, o, mref, mxrun, l); \
                fin = (t == 0) || __all(bqbk + fwin[t > 0 ? kv0 - 1 : 0] + FrL < mref + mxrun - ATT_THR); } } \
        if (lane == 0) flagb[(s & 1) * 8 + wave] = fin ? 1 : 0; \
        ++s; }
    for (;;) { ATTU_STEP(0) ATTU_STEP(1) ATTU_STEP(2) }
#undef ATTU_STEP
    asm volatile("s_waitcnt vmcnt(0) lgkmcnt(0)\n\ts_barrier" ::: "memory");
#undef ATTU_DMA
    if (!domath) return;
    float inv = 1.f;
    if constexpr (!SB) { l += __shfl_xor(l, 32); inv = 1.f / l; }
    bf16* op = O + (rowb + q0 + r32) * D + hc + 4 * hi;
#pragma unroll
    for (int d0 = 0; d0 < 2; ++d0)
#pragma unroll
        for (int g = 0; g < 4; ++g) { v2u w; w.x = cvtpk(o[d0][4 * g] * inv, o[d0][4 * g + 1] * inv); w.y = cvtpk(o[d0][4 * g + 2] * inv, o[d0][4 * g + 3] * inv); *(v2u*)(op + 32 * d0 + 8 * g) = w; }
}
}

struct Frame {
    LAS unsigned char* lds;
    int tid, lane, wave, vcu, G;
};
__device__ __forceinline__ int opaque_tid(int wave_s) { int l; asm volatile("v_mbcnt_lo_u32_b32 %0, -1, 0\n\tv_mbcnt_hi_u32_b32 %0, -1, %0" : "=v"(l)); return wave_s * 64 + l; }
#define PHASE_IDS const int tid = opaque_tid(wave_s); const int lane = tid & 63; const int wave = __builtin_amdgcn_readfirstlane(tid >> 6); F.tid = tid; F.lane = lane; F.wave = wave
__device__ __forceinline__ float wave_sum(float v) {
#pragma unroll
    for (int o = 1; o < 64; o <<= 1) v += __shfl_xor(v, o);
    return v;
}
__device__ __forceinline__ float sigmoid_f(float v) { return 1.f / (1.f + __expf(-v)); }
__device__ __forceinline__ float log_sigmoid_f(float v) { return fminf(v, 0.f) - log1pf(expf(-fabsf(v))); }

struct TrItem { const float* src; bf16* dst; int ldw, ldt; float fp8scale; };
__device__ __forceinline__ void tr_load(const TrItem& t, f32x4 (&r)[8], int lane) {
#pragma unroll
    for (int i = 0; i < 8; ++i) r[i] = *(const GAS f32x4*)(t.src + (size_t)((lane >> 3) + 8 * i) * t.ldw + 4 * (lane & 7));
}
__device__ __forceinline__ void tr_finish(const TrItem& t, const f32x4 (&r)[8], LAS float* scr, int lane) {
#pragma unroll
    for (int i = 0; i < 8; ++i) { LAS float* p = scr + ((lane >> 3) + 8 * i) * 33 + 4 * (lane & 7); p[0] = r[i].x; p[1] = r[i].y; p[2] = r[i].z; p[3] = r[i].w; }
    LDS_WAIT(); asm volatile("" ::: "memory");
    const int c = lane & 7;
    if (t.fp8scale != 0.f) {
        const float sc = t.fp8scale;
#pragma unroll
        for (int j = 0; j < 4; ++j) { const int n = (lane >> 3) + 8 * j; const LAS float* s = scr + (8 * c) * 33 + n;
            unsigned w0 = __builtin_amdgcn_cvt_pk_fp8_f32(s[0 * 33] * sc, s[1 * 33] * sc, 0, false); w0 = __builtin_amdgcn_cvt_pk_fp8_f32(s[2 * 33] * sc, s[3 * 33] * sc, w0, true);
            unsigned w1 = __builtin_amdgcn_cvt_pk_fp8_f32(s[4 * 33] * sc, s[5 * 33] * sc, 0, false); w1 = __builtin_amdgcn_cvt_pk_fp8_f32(s[6 * 33] * sc, s[7 * 33] * sc, w1, true);
            *(GAS v2u*)((unsigned char*)t.dst + (size_t)n * t.ldt + 8 * c) = (v2u){w0, w1}; }
    } else {
#pragma unroll
    for (int j = 0; j < 4; ++j) { const int n = (lane >> 3) + 8 * j; const LAS float* s = scr + (8 * c) * 33 + n;
        v4u o; o.x = pk2(s[0 * 33], s[1 * 33]); o.y = pk2(s[2 * 33], s[3 * 33]); o.z = pk2(s[4 * 33], s[5 * 33]); o.w = pk2(s[6 * 33], s[7 * 33]);
        *(GAS v4u*)(t.dst + (size_t)n * t.ldt + 8 * c) = o; }
    }
    LDS_WAIT(); asm volatile("" ::: "memory");
}
__device__ __forceinline__ int win_src_col(int n0) {
    if (n0 < 512) return n0;
    if (n0 < 1024) return 1544 + (n0 - 512);
    if (n0 < 1536) return 512 + (n0 - 1024);
    if (n0 < 2048) return 2056 + (n0 - 1536);
    if (n0 < 2560) return 1024 + (n0 - 2048);
    if (n0 < 3072) return 2568 + (n0 - 2560);
    if (n0 < 4096) return 3080 + (n0 - 3072);
    return 4104 + (n0 - 4096);
}

struct Args { const float* in[19]; float* out; unsigned char* ws; int ph_lo, ph_hi; };


#define P1N_LOAD(buf, p) do { const GAS f32x4* xa_ = (const GAS f32x4*)(x + (size_t)(rb * 128 + wave + 16 * (p)) * D) + lane; \
        _Pragma("unroll") for (int j = 0; j < 4; ++j) { buf[0][j] = xa_[64 * j]; buf[1][j] = xa_[64 * j + 8 * (D / 4)]; } } while (0)
#define P1N_PAIR(buf, p) do { const int m0 = rb * 128 + wave + 16 * (p); \
        float ss0 = 0.f, ss1 = 0.f; \
        _Pragma("unroll") for (int j = 0; j < 4; ++j) { ss0 += (buf[0][j].x * buf[0][j].x + buf[0][j].y * buf[0][j].y) + (buf[0][j].z * buf[0][j].z + buf[0][j].w * buf[0][j].w); \
                                                        ss1 += (buf[1][j].x * buf[1][j].x + buf[1][j].y * buf[1][j].y) + (buf[1][j].z * buf[1][j].z + buf[1][j].w * buf[1][j].w); } \
        const float rstd0 = __builtin_amdgcn_rsqf(wave_sum(ss0) * (1.f / D) + RMS_EPS), rstd1 = __builtin_amdgcn_rsqf(wave_sum(ss1) * (1.f / D) + RMS_EPS); \
        f32x4 fa[2][2]; fa[0][0] = fa[0][1] = fa[1][0] = fa[1][1] = (f32x4){0.f, 0.f, 0.f, 0.f}; \
        GAS v2u* o8 = (GAS v2u*)(XN + (size_t)m0 * D) + lane; GAS unsigned* o4 = (GAS unsigned*)(XN8 + (size_t)m0 * D) + lane; \
        _Pragma("unroll") for (int j = 0; j < 4; ++j) { asm volatile("" ::: "memory"); const f32x4 g = *(const LAS f32x4*)(gsl + 4 * lane + 256 * j), sh = *(const LAS f32x4*)(shl + 4 * lane + 256 * j); \
            const f32x4 h0 = buf[0][j] * rstd0 * g + sh, h1 = buf[1][j] * rstd1 * g + sh; \
            o8[64 * j] = (v2u){att::cvtpk(h0.x, h0.y), att::cvtpk(h0.z, h0.w)}; o8[64 * j + 8 * (D / 4)] = (v2u){att::cvtpk(h1.x, h1.y), att::cvtpk(h1.z, h1.w)}; \
            { unsigned w8 = __builtin_amdgcn_cvt_pk_fp8_f32(h0.x, h0.y, 0, false); w8 = __builtin_amdgcn_cvt_pk_fp8_f32(h0.z, h0.w, w8, true); o4[64 * j] = w8; } \
            { unsigned w8 = __builtin_amdgcn_cvt_pk_fp8_f32(h1.x, h1.y, 0, false); w8 = __builtin_amdgcn_cvt_pk_fp8_f32(h1.z, h1.w, w8, true); o4[64 * j + 8 * (D / 4)] = w8; } \
            _Pragma("unroll") for (int c = 0; c < 4; ++c) { const f32x4 wa_ = wl[((j * 4 + c) * 2) * 64 + lane], wb_ = wl[((j * 4 + c) * 2 + 1) * 64 + lane]; \
                fa[0][0] += h0[c] * wa_; fa[0][1] += h0[c] * wb_; fa[1][0] += h1[c] * wa_; fa[1][1] += h1[c] * wb_; } } \
        _Pragma("unroll") for (int rr = 0; rr < 2; ++rr) { float g4[4], g2[2], g1;   \
            { const bool up = (lane & 32) != 0; const float f[8] = {fa[rr][0].x, fa[rr][0].y, fa[rr][0].z, fa[rr][0].w, fa[rr][1].x, fa[rr][1].y, fa[rr][1].z, fa[rr][1].w}; \
              _Pragma("unroll") for (int c = 0; c < 4; ++c) { const float snd = up ? f[c] : f[c + 4], kp = up ? f[c + 4] : f[c]; g4[c] = kp + __shfl_xor(snd, 32); } } \
            { const bool up = (lane & 16) != 0; \
              _Pragma("unroll") for (int c = 0; c < 2; ++c) { const float snd = up ? g4[c] : g4[c + 2], kp = up ? g4[c + 2] : g4[c]; g2[c] = kp + __shfl_xor(snd, 16); } } \
            { const bool up = (lane & 8) != 0; const float snd = up ? g2[0] : g2[1], kp = up ? g2[1] : g2[0]; g1 = kp + __shfl_xor(snd, 8); } \
            g1 += __shfl_xor(g1, 4); g1 += __shfl_xor(g1, 2); g1 += __shfl_xor(g1, 1); \
            if ((lane & 7) == 0) { const float val = g1 + bfg; LOGF[(size_t)(b * 8 + (lane >> 3)) * SEQ + ((m0 + 8 * rr) % SEQ)] = fminf(val, 0.f) - __logf(1.f + __expf(-fabsf(val))); } } } while (0)
__device__ __forceinline__ void p1_norm(const Args& args, Frame& F, const float* x, bf16* XN, unsigned char* XN8, float* LOGF, const float* mod) {
    const int wave = F.wave;
    LAS float* gsl = (LAS float*)(F.lds + TAB_OFF);
    LAS float* shl = (LAS float*)(F.lds + TAB_OFF + 4096);
    LAS f32x4* wl = (LAS f32x4*)F.lds;
    for (int rb = F.vcu; rb < NTOK / 128; rb += F.G) {
        const int b = rb / 32;
        int lane = F.lane; asm volatile("" : "+v"(lane));
        __syncthreads();
        for (int k = wave * 64 + lane; k < D; k += NWAVES * 64) { gsl[k] = args.in[4][k] * (1.f + mod[b * NMOD * D + D + k]); shl[k] = mod[b * NMOD * D + k]; }
#pragma unroll
        for (int q4 = 0; q4 < 4; ++q4) { const int q = wave * 4 + q4, jc = q >> 1, k = 4 * lane + 256 * (jc >> 2) + (jc & 3);
            wl[q * 64 + lane] = *(const f32x4*)(args.in[5] + (size_t)k * NIN + 1536 + 4 * (q & 1)); }
        __syncthreads();
        const float bfg = args.in[6][(lane >> 3) & 7];
        f32x4 A[2][4], B[2][4];
        P1N_LOAD(A, 0);
        _Pragma("nounroll") for (int p = 0; p < 8; p += 2) {
            P1N_LOAD(B, p + 1);
            P1N_PAIR(A, p);
            if (p + 2 < 8) P1N_LOAD(A, p + 2);
            P1N_PAIR(B, p + 1);
        }
    }
}
#undef P1N_LOAD
#undef P1N_PAIR
__device__ __forceinline__ TrItem tr_decode(const Args& args, int it, bf16* WIN, unsigned char* WIN8, bf16* WBR, bf16* WOUT, bf16* WGU, bf16* WD) {
    constexpr int I_WIN = 16 * 160, I_BR = 8 * 32, I_OUT = 16 * 32, I_G = 16 * 256;
    int r = it; TrItem t; t.fp8scale = 0.f;
    if (r < I_WIN) { const int kb = r / 160, nb = r % 160; t.src = args.in[5] + (size_t)(64 * kb) * NIN + win_src_col(32 * nb); t.ldw = NIN;
        if (nb < 64) { t.dst = WIN + (size_t)(32 * nb) * D + 64 * kb; t.ldt = D; }
        else if (nb < 96) { t.dst = (bf16*)(WIN8 + (size_t)(2048 + 32 * (nb - 64)) * D + 64 * kb); t.ldt = D; t.fp8scale = 32.f; }
        else { t.dst = (bf16*)(WIN8 + (size_t)(32 * (nb - 96)) * D + 64 * kb); t.ldt = D; t.fp8scale = 32.f; }
        return t; } r -= I_WIN;
    if (r < I_BR) { const int kb = r / 32, nb = r % 32; t.src = args.in[7] + (size_t)(64 * kb) * D + 32 * nb; t.ldw = D; t.dst = WBR + (size_t)(32 * nb) * D + 64 * kb; t.ldt = D; return t; } r -= I_BR;
    if (r < I_BR) { const int kb = r / 32, nb = r % 32; t.src = args.in[8] + (size_t)(64 * kb) * D + 32 * nb; t.ldw = D; t.dst = WBR + (size_t)(32 * nb) * D + 512 + 64 * kb; t.ldt = D; return t; } r -= I_BR;
    if (r < I_OUT) { const int kb = r / 32, nb = r % 32; t.src = args.in[9] + (size_t)(64 * kb) * D + 32 * nb; t.ldw = D; t.dst = WOUT + (size_t)(32 * nb) * D + 64 * kb; t.ldt = D; return t; } r -= I_OUT;
    if (r < 2 * I_G) { const int up = r / I_G; r -= up * I_G; const int e = r / 256, q = r % 256, kb = q / 16, nb = q % 16, n0 = 32 * nb;
        t.src = args.in[15 + up] + (size_t)e * D * DFF + (size_t)(64 * kb) * DFF + n0; t.ldw = DFF;
        t.dst = (bf16*)((unsigned char*)WGU + (size_t)e * D * D + (size_t)(256 * (n0 / 128) + (n0 % 128) + 128 * up) * D + 64 * kb); t.ldt = D; t.fp8scale = 32.f; return t; } r -= 2 * I_G;
    { const int e = r / 256, q = r % 256, kb = q / 32, nb = q % 32; t.src = args.in[17] + (size_t)e * DFF * D + (size_t)(64 * kb) * D + 32 * nb; t.ldw = D;
      t.dst = (bf16*)((unsigned char*)WD + (size_t)e * D * DFF + (size_t)(32 * nb) * DFF + 64 * kb); t.ldt = DFF; t.fp8scale = 16.f; return t; }
}
__device__ __forceinline__ void p1_trans(const Args& args, Frame& F, bf16* WIN, unsigned char* WIN8, bf16* WBR, bf16* WOUT, bf16* WGU, bf16* WD) {
    const int lane = F.lane, wave = F.wave; const int gw = F.vcu * NWAVES + wave, NGW = F.G * NWAVES;
    LAS float* scr = (LAS float*)(F.lds + wave * 16384);
    constexpr int NITEMS = 16 * 160 + 2 * 8 * 32 + 16 * 32 + 2 * 16 * 256 + 16 * 256;
    if (gw >= NITEMS) return;
    f32x4 ra[8], rb[8];
    TrItem cur = tr_decode(args, gw, WIN, WIN8, WBR, WOUT, WGU, WD);
    tr_load(cur, ra, lane);
    for (int it = gw; it < NITEMS; it += NGW) {
        const int nx = it + NGW; TrItem nt = cur;
        if (nx < NITEMS) { nt = tr_decode(args, nx, WIN, WIN8, WBR, WOUT, WGU, WD); tr_load(nt, rb, lane); }
        tr_finish(cur, ra, scr, lane);
#pragma unroll
        for (int i = 0; i < 8; ++i) ra[i] = rb[i];
        cur = nt;
    }
}

__global__ void __launch_bounds__(NWAVES * 64, 2) fwd(Args args) {
    extern __shared__ __attribute__((aligned(16))) unsigned char lds_raw[];
    Frame F;
    F.lds = (LAS unsigned char*)lds_raw;
    const int wave_s = __builtin_amdgcn_readfirstlane((int)threadIdx.x >> 6);
    F.tid = threadIdx.x; F.lane = F.tid & 63; F.wave = wave_s;
    F.G = gridDim.x; { const int bx = blockIdx.x; F.vcu = (F.G % 8 == 0) ? (bx % 8) * (F.G / 8) + bx / 8 : bx; }
    unsigned char* ws = args.ws;
    unsigned* ctl = (unsigned*)(ws + WS_CTL);
    volatile LAS unsigned* MISC = (volatile LAS unsigned*)(F.lds + MISC_OFF);
    for (int u = F.tid; u < 256; u += NWAVES * 64) ((LAS unsigned*)(F.lds + MISC_OFF))[u] = 0u;
    __syncthreads();
    XcdBarrier bar = xcd_barrier_post(ctl + CW_BAR, MISC + 8, F.tid);
    unsigned long long pc0_; asm volatile("s_getpc_b64 %0" : "=s"(pc0_));
    const unsigned char* cwarm = (const unsigned char*)((pc0_ + 127ull) & ~127ull) + (size_t)(F.vcu & 31) * 4864;
    LAS unsigned char* cjunk = F.lds + MISC_OFF + 512;
    const int lo = args.ph_lo, hi = args.ph_hi;
#define IN(k) (lo <= (k) && (k) < hi)
#define BOTH(k) (IN(k) && IN((k) + 1))
    float* mod = (float*)(ws + WS_MOD);
    float* LOGF = (float*)(ws + WS_LOGF);
    float* FC = (float*)(ws + WS_F);
    bf16* WIN = (bf16*)(ws + WS_WIN); bf16* WBR = (bf16*)(ws + WS_WBR); bf16* WOUT = (bf16*)(ws + WS_WOUT); bf16* WGU = (bf16*)(ws + WS_WGU); bf16* WD = (bf16*)(ws + WS_WD);
    bf16* XN = (bf16*)(ws + WS_XN); bf16* QB = (bf16*)(ws + WS_Q); bf16* KB = (bf16*)(ws + WS_K); bf16* VB = (bf16*)(ws + WS_V); bf16* GAB = (bf16*)(ws + WS_GA); bf16* GBB = (bf16*)(ws + WS_GB);
    bf16* ACT = (bf16*)(ws + WS_ACT); bf16* YB = (bf16*)(ws + WS_Y); bf16* X1B = (bf16*)(ws + WS_V);
    int* LIST = (int*)(ws + WS_LIST); float* LW = (float*)(ws + WS_LW);
    const float* x = args.in[0];

    if (IN(0)) _Pragma("nounroll") for (int rep_ = 0; rep_ < NREP0; ++rep_) {
        PHASE_IDS;
        LAS float* cs = (LAS float*)F.lds;
        LAS float* red = (LAS float*)(F.lds + 32768);
        for (int i = tid; i < BATCH * D; i += NWAVES * 64) { const float v = args.in[1][i]; cs[i] = v / (1.f + expf(-v)); }
        __syncthreads();
        if (F.vcu < 192) {
            const int cc = tid & 31, ks = tid >> 5, col = F.vcu * 32 + cc;
            float a[8];
#pragma unroll
            for (int b = 0; b < 8; ++b) a[b] = 0.f;
            const float* wp = args.in[2] + col;
            for (int k0 = ks * 64; k0 < ks * 64 + 64; k0 += 16) { float w[16];
#pragma unroll
                for (int i = 0; i < 16; ++i) w[i] = wp[(size_t)(k0 + i) * (NMOD * D)];
#pragma unroll
                for (int i = 0; i < 16; ++i)
#pragma unroll
                    for (int b = 0; b < 8; ++b) a[b] += cs[b * D + k0 + i] * w[i]; }
#pragma unroll
            for (int b = 0; b < 8; ++b) red[(ks * 8 + b) * 32 + cc] = a[b];
            __syncthreads();
            if (tid < 256) { const int b = tid >> 5; float s = 0.f;
#pragma unroll
                for (int q = 0; q < 16; ++q) s += red[(q * 8 + b) * 32 + cc];
                mod[b * (NMOD * D) + F.vcu * 32 + cc] = s + args.in[3][F.vcu * 32 + cc]; }
        }
        asm volatile("s_waitcnt vmcnt(0)" ::: "memory");
        __syncthreads();
        if (tid == 0 && F.vcu < 192) { __builtin_amdgcn_fence(__ATOMIC_RELEASE, "agent"); asm volatile("s_waitcnt vmcnt(0)" ::: "memory"); (void)xb_add(ctl + CW_MODCNT, 1u); }
    }

    if (IN(1)) _Pragma("nounroll") for (int rep_ = 0; rep_ < NREP1; ++rep_) {
        PHASE_IDS;
        p1_trans(args, F, WIN, (unsigned char*)(ws + WS_WIN8), WBR, WOUT, WGU, WD);
        if (tid == 0) { unsigned sp = 0; while (xb_ld(ctl + CW_MODCNT) < 192u) { __builtin_amdgcn_s_sleep(2); if (++sp > (1u << 22)) break; }
            __builtin_amdgcn_fence(__ATOMIC_ACQUIRE, "agent"); asm volatile("s_waitcnt vmcnt(0)" ::: "memory"); }
        __syncthreads();
        p1_norm(args, F, x, XN, (unsigned char*)(ws + WS_XN8), LOGF, mod);
        if (BOTH(1)) xcd_barrier(bar, opaque_tid(wave_s), cwarm, cjunk);
    }

    if (IN(2)) _Pragma("nounroll") for (int rep_ = 0; rep_ < NREP2; ++rep_) {
        PHASE_IDS;
        for (int bh = F.vcu; bh < 64; bh += F.G) {
            LAS float* wt = (LAS float*)F.lds;
            const float* src = LOGF + (size_t)bh * SEQ + tid * 8; float* dst = FC + (size_t)bh * SEQ + tid * 8;
            const f32x4 a = *(const f32x4*)src, c = *(const f32x4*)(src + 4);
            float p[8]; p[0] = a.x; p[1] = p[0] + a.y; p[2] = p[1] + a.z; p[3] = p[2] + a.w; p[4] = p[3] + c.x; p[5] = p[4] + c.y; p[6] = p[5] + c.z; p[7] = p[6] + c.w;
            float incl = p[7];
#pragma unroll
            for (int o = 1; o < 64; o <<= 1) { const float t = __shfl_up(incl, o); if (lane >= o) incl += t; }
            if (lane == 63) wt[wave] = incl;
            __syncthreads();
            float base = incl - p[7];
            for (int w = 0; w < wave; ++w) base += wt[w];
            *(f32x4*)dst = (f32x4){p[0] + base, p[1] + base, p[2] + base, p[3] + base}; *(f32x4*)(dst + 4) = (f32x4){p[4] + base, p[5] + base, p[6] + base, p[7] + base};
            __syncthreads();
        }
        { pg8::Gemm g{(const bf16*)(ws + WS_XN8), (const bf16*)(ws + WS_WIN8 + (size_t)2048 * D), D / 2, D / 2, D / 2, 127, 127}; pg8::StaticOrder S; S.init(NTOK, D, F.G, (int)blockIdx.x, GREP2);
          pg8::EpiSplit E{VB, D, D, 0, 1.f, nullptr, 0.03125f, false};
          pg8::gemm_phase<pg8::EpiSplit, pg8::StaticOrder, true, false, true>(F.lds, g, S, E, nullptr, tid); }
        { pg8::Gemm g{XN, WIN, D, D, D, 127, 127}; pg8::StaticOrder S; S.init(NTOK, 2 * D, F.G, (int)blockIdx.x, GREP2);
          pg8::EpiSplit E{QB, D, D, (size_t)(WS_K - WS_Q) / 2, C2, ctl + CW_KMAX, 1.f, false};
          pg8::gemm_phase<pg8::EpiSplit, pg8::StaticOrder, true, false>(F.lds, g, S, E, nullptr, opaque_tid(wave_s)); }
        if (BOTH(2)) xcd_barrier(bar, opaque_tid(wave_s), cwarm, cjunk);
    }

    if (IN(3)) _Pragma("nounroll") for (int rep_ = 0; rep_ < NREP3; ++rep_) {
        PHASE_IDS;
        for (int uid = F.vcu; uid < 2048; uid += F.G) {
            const int type = uid >> 10, idx = uid & 1023, bh = idx >> 4, b = bh >> 3, h = bh & 7, q0u = (idx & 15) * 256;
            if (type == 0) {
                const float k2 = __builtin_bit_cast(float, __hip_atomic_load(ctl + CW_KMAX + bh * 2, __ATOMIC_RELAXED, __HIP_MEMORY_SCOPE_AGENT)) + __builtin_bit_cast(float, __hip_atomic_load(ctl + CW_KMAX + bh * 2 + 1, __ATOMIC_RELAXED, __HIP_MEMORY_SCOPE_AGENT));
                att::attn_unit<false>(b, h * 64, q0u, QB, KB, VB, XN, FC + (size_t)bh * SEQ, k2, F.lds, (LAS unsigned char*)(F.lds + MISC_OFF + 128), wave, lane, !(PROBE_ATT == 3 && rep_ != NREP3 - 1));
            } else {
                att::attn_unit<true>(b, 512 + h * 64, q0u, QB, KB, VB, XN, nullptr, 0.f, F.lds, (LAS unsigned char*)(F.lds + MISC_OFF + 128), wave, opaque_tid(wave_s) & 63, !(PROBE_ATT == 3 && rep_ != NREP3 - 1));
            }
        }
        if (BOTH(3)) xcd_barrier(bar, opaque_tid(wave_s), cwarm, cjunk);
    }

    if (IN(4)) _Pragma("nounroll") for (int rep_ = 0; rep_ < NREP4; ++rep_) {
        PHASE_IDS;
        { pg8::Gemm g{(const bf16*)(ws + WS_XN8), (const bf16*)(ws + WS_WIN8), D / 2, D / 2, D / 2, 127, 127}; pg8::GateOrder S; S.M.init(NTOK, D, F.G, (int)blockIdx.x, GREP4);
          pg8::EpiGate8 E{(unsigned char*)GAB, 0.03125f};
          pg8::gemm_phase<pg8::EpiGate8, pg8::GateOrder, true, false, true>(F.lds, g, S, E, nullptr, tid); }
        { pg8::Gemm g{XN, WBR, D, D, D, 127, 127}; pg8::StaticOrder S; S.init(NTOK, D, F.G, (int)blockIdx.x, GREP4);
          pg8::EpiMerge E{(const unsigned char*)GAB, KB};
          pg8::gemm_phase<pg8::EpiMerge, pg8::StaticOrder, true, false>(F.lds, g, S, E, nullptr, opaque_tid(wave_s)); }
        if (BOTH(4)) xcd_barrier(bar, opaque_tid(wave_s), cwarm, cjunk);
    }

    if (IN(5)) _Pragma("nounroll") for (int rep_ = 0; rep_ < NREP5; ++rep_) {
        PHASE_IDS;
        pg8::Gemm g{KB, WOUT, D, D, D, 127, 127}; pg8::StaticOrder S; S.init(NTOK, D, F.G, (int)blockIdx.x, GREP5);
        pg8::EpiResid E{x, mod + 2 * D, X1B, (float*)(ws + WS_LOGF)};
        pg8::gemm_phase<pg8::EpiResid, pg8::StaticOrder, true, false>(F.lds, g, S, E, nullptr, tid);
        if (BOTH(5)) xcd_barrier(bar, opaque_tid(wave_s), cwarm, cjunk);
    }

    if (IN(6)) _Pragma("nounroll") for (int rep_ = 0; rep_ < NREP6; ++rep_) {
        PHASE_IDS;
        LAS v4u* BH0 = (LAS v4u*)F.lds;
        LAS v4u* BL0 = (LAS v4u*)(F.lds + 32768);
        LAS v4u* BH1 = (LAS v4u*)(F.lds + 65536);
        LAS v4u* BL1 = (LAS v4u*)(F.lds + 73728);
        LAS float* gsl = (LAS float*)(F.lds + 81920);
        LAS float* shl = (LAS float*)(F.lds + 86016);
        LAS float* lsc = (LAS float*)(F.lds + 90112) + wave * 320;
        LAS int* selE = (LAS int*)(F.lds + 100352);
        LAS float* selW = (LAS float*)(F.lds + 100864);
        LAS int* lcnt = (LAS int*)(F.lds + 101888);
        LAS int* lpos = (LAS int*)(F.lds + 102016);
        const float* SSQ = (const float*)(ws + WS_LOGF);
#pragma unroll
        for (int it_ = 0; it_ < 5; ++it_) { const int en = tid + it_ * (NWAVES * 64);
            float w[8];
            if (en < 2048) { const int s_ = en >> 6, ln = en & 63, c = ln & 15, kg = ln >> 4;
#pragma unroll
                for (int j = 0; j < 8; ++j) w[j] = args.in[13][(size_t)(128 * (s_ >> 2) + 32 * kg + 8 * (s_ & 3) + j) * 16 + c]; }
            else { const int e2 = en - 2048, s_ = e2 >> 4, kg = (e2 >> 2) & 3, c = e2 & 3;
#pragma unroll
                for (int j = 0; j < 8; ++j) w[j] = args.in[11][(size_t)(128 * (s_ >> 2) + 32 * kg + 8 * (s_ & 3) + j) * 4 + c]; }
            v4u hi4, lo4;
#pragma unroll
            for (int j = 0; j < 4; ++j) { const unsigned hp = att::cvtpk(w[2 * j], w[2 * j + 1]); hi4[j] = hp; lo4[j] = att::cvtpk(w[2 * j] - bflo(hp), w[2 * j + 1] - bfhi(hp)); }
            if (en < 2048) { BH0[en] = hi4; BL0[en] = lo4; } else { BH1[en - 2048] = hi4; BL1[en - 2048] = lo4; }
        }
        for (int rb = F.vcu; rb < NTOK / 128; rb += F.G) {
        const int b = rb / 32;
        __syncthreads();
        if (tid < 32) lcnt[tid] = 0;
        for (int k = tid; k < D; k += NWAVES * 64) { gsl[k] = args.in[10][k] * (1.f + mod[b * NMOD * D + 4 * D + k]); shl[k] = mod[b * NMOD * D + 3 * D + k]; }
        __syncthreads();
        {
            int ln6 = lane; asm volatile("" : "+v"(ln6));
            const int rw = ln6 & 15, kg = ln6 >> 4, m = rb * 128 + wave * 16 + rw;
            v4u xall[8][4];
            { const bf16* xr_ = X1B + (size_t)m * D + 32 * kg;
#pragma unroll
              for (int S = 0; S < 8; ++S)
#pragma unroll
                  for (int q = 0; q < 4; ++q) xall[S][q] = *(const v4u*)(xr_ + 128 * S + 8 * q); }
            float ssq = 0.f;
#pragma unroll
            for (int i = 0; i < 4; ++i) { const f32x4 t4 = *(const f32x4*)(SSQ + (size_t)m * 16 + 4 * i); ssq += (t4.x + t4.y) + (t4.z + t4.w); }
            const float rstd = __builtin_amdgcn_rsqf(ssq * (1.f / D) + RMS_EPS);
            const bf16* xrow = X1B + (size_t)m * D + 32 * kg; unsigned char* hrow = (unsigned char*)XN + (size_t)m * D + 32 * kg;
            f32x4 acc0 = (f32x4){0.f, 0.f, 0.f, 0.f}, acc1 = acc0;
#pragma unroll
            for (int S = 0; S < 8; ++S) {
                asm volatile("" ::: "memory");
                unsigned h8[8];
#pragma unroll
                for (int q = 0; q < 4; ++q) { const int s_ = 4 * S + q, k0 = 128 * S + 32 * kg + 8 * q; const v4u xq = xall[S][q];
                    const f32x4 ga = *(const LAS f32x4*)(gsl + k0), gb = *(const LAS f32x4*)(gsl + k0 + 4);
                    const f32x4 sa = *(const LAS f32x4*)(shl + k0), sb = *(const LAS f32x4*)(shl + k0 + 4);
                    const f32x4 xa_ = (f32x4){bflo(xq.x), bfhi(xq.x), bflo(xq.y), bfhi(xq.y)}, xb_ = (f32x4){bflo(xq.z), bfhi(xq.z), bflo(xq.w), bfhi(xq.w)};
                    const f32x4 ha = xa_ * rstd * ga + sa, hb = xb_ * rstd * gb + sb;
                    v4u hi4, lo4;
                    hi4.x = att::cvtpk(ha.x, ha.y); hi4.y = att::cvtpk(ha.z, ha.w); hi4.z = att::cvtpk(hb.x, hb.y); hi4.w = att::cvtpk(hb.z, hb.w);
                    lo4.x = att::cvtpk(ha.x - bflo(hi4.x), ha.y - bfhi(hi4.x)); lo4.y = att::cvtpk(ha.z - bflo(hi4.y), ha.w - bfhi(hi4.y));
                    lo4.z = att::cvtpk(hb.x - bflo(hi4.z), hb.y - bfhi(hi4.z)); lo4.w = att::cvtpk(hb.z - bflo(hi4.w), hb.w - bfhi(hi4.w));
                    { unsigned w0 = __builtin_amdgcn_cvt_pk_fp8_f32(ha.x, ha.y, 0, false); w0 = __builtin_amdgcn_cvt_pk_fp8_f32(ha.z, ha.w, w0, true);
                      unsigned w1 = __builtin_amdgcn_cvt_pk_fp8_f32(hb.x, hb.y, 0, false); w1 = __builtin_amdgcn_cvt_pk_fp8_f32(hb.z, hb.w, w1, true);
                      h8[2 * q] = w0; h8[2 * q + 1] = w1; }
                    const bf16x8 ah = __builtin_bit_cast(bf16x8, hi4), al = __builtin_bit_cast(bf16x8, lo4);
                    const bf16x8 bh0 = __builtin_bit_cast(bf16x8, BH0[s_ * 64 + ln6]), bl0 = __builtin_bit_cast(bf16x8, BL0[s_ * 64 + ln6]);
                    const bf16x8 bh1 = __builtin_bit_cast(bf16x8, BH1[s_ * 16 + kg * 4 + (rw & 3)]), bl1 = __builtin_bit_cast(bf16x8, BL1[s_ * 16 + kg * 4 + (rw & 3)]);
                    acc0 = __builtin_amdgcn_mfma_f32_16x16x32_bf16(ah, bh0, acc0, 0, 0, 0); acc0 = __builtin_amdgcn_mfma_f32_16x16x32_bf16(al, bh0, acc0, 0, 0, 0); acc0 = __builtin_amdgcn_mfma_f32_16x16x32_bf16(ah, bl0, acc0, 0, 0, 0);
                    acc1 = __builtin_amdgcn_mfma_f32_16x16x32_bf16(ah, bh1, acc1, 0, 0, 0); acc1 = __builtin_amdgcn_mfma_f32_16x16x32_bf16(al, bh1, acc1, 0, 0, 0); acc1 = __builtin_amdgcn_mfma_f32_16x16x32_bf16(ah, bl1, acc1, 0, 0, 0);
                }
                *(v4u*)(hrow + 128 * S) = (v4u){h8[0], h8[1], h8[2], h8[3]}; *(v4u*)(hrow + 128 * S + 16) = (v4u){h8[4], h8[5], h8[6], h8[7]};
            }
#pragma unroll
            for (int i = 0; i < 4; ++i) { lsc[(4 * kg + i) * 20 + 4 + rw] = acc0[i]; if (rw < 4) lsc[(4 * kg + i) * 20 + rw] = acc1[i]; }
            LDS_WAIT(); asm volatile("" ::: "memory");
            if (lane < 16) {
                float lg[20];
#pragma unroll
                for (int i = 0; i < 20; ++i) lg[i] = lsc[lane * 20 + i];
#pragma unroll
                for (int i = 0; i < 4; ++i) lg[i] += args.in[12][i];
#pragma unroll
                for (int i = 0; i < 16; ++i) lg[4 + i] += args.in[14][i];
                int gi = 0; float gm = lg[0];
#pragma unroll
                for (int i = 1; i < 4; ++i) if (lg[i] > gm) { gm = lg[i]; gi = i; }
                float gsum = 0.f;
#pragma unroll
                for (int i = 0; i < 4; ++i) gsum += expf(lg[i] - gm);
                const float gp = 1.f / gsum;
                float es[4];
#pragma unroll
                for (int i = 0; i < 4; ++i) es[i] = (gi == 0) ? lg[4 + i] : (gi == 1) ? lg[8 + i] : (gi == 2) ? lg[12 + i] : lg[16 + i];
                int i1 = 0; float m1 = es[0];
#pragma unroll
                for (int i = 1; i < 4; ++i) if (es[i] > m1) { m1 = es[i]; i1 = i; }
                int i2 = -1; float m2 = -3.0e38f;
#pragma unroll
                for (int i = 0; i < 4; ++i) if (i != i1 && es[i] > m2) { m2 = es[i]; i2 = i; }
                const float p2 = expf(m2 - m1), inv = 1.f / (1.f + p2);
                const int rl = wave * 16 + lane;
                selE[rl] = (gi * 4 + i1) | ((gi * 4 + i2) << 8); selW[2 * rl] = gp * inv; selW[2 * rl + 1] = gp * p2 * inv;
            }
        }
        __syncthreads();
        int my_e = 0;
        if (rep_ == NREP6 - 1) {
        if (tid < 256) { const int se = selE[tid >> 1]; my_e = (tid & 1) ? (se >> 8) & 255 : se & 255; lpos[tid] = __hip_atomic_fetch_add(&lcnt[my_e], 1, __ATOMIC_RELAXED, __HIP_MEMORY_SCOPE_WORKGROUP); }
        __syncthreads();
        if (tid < 16) lcnt[16 + tid] = (int)__hip_atomic_fetch_add(ctl + CW_CNT + 64 * tid, (unsigned)lcnt[tid], __ATOMIC_RELAXED, __HIP_MEMORY_SCOPE_AGENT);
        __syncthreads();
        if (tid < 256) { const int pos = lcnt[16 + my_e] + lpos[tid]; LIST[my_e * NTOK + pos] = (rb * 128 + (tid >> 1)) * 2 + (tid & 1); LW[my_e * NTOK + pos] = selW[tid]; }
        }
        }
        if (BOTH(6)) xcd_barrier(bar, opaque_tid(wave_s), cwarm, cjunk);
    }

    LAS int* tab = (LAS int*)(F.lds + TAB_OFF);
    LAS int* gtab = (LAS int*)(F.lds + TAB_OFF + 512);
    if (IN(7) || IN(8)) {
        PHASE_IDS;
        if (tid < 16) tab[32 + tid] = (int)__hip_atomic_load(ctl + CW_CNT + 64 * tid, __ATOMIC_RELAXED, __HIP_MEMORY_SCOPE_AGENT);
        __syncthreads();
        if (tid == 0) { int acc_t = 0;
            for (int e = 0; e < 16; ++e) { const int c = tab[32 + e]; tab[e] = acc_t; acc_t += (c + 255) >> 8; }
            tab[16] = acc_t;
            const int nun = acc_t * 4; int cnt_u = 0; LAS int* ul = tab + 64;
            for (int i = 0; i < 14; ++i) { int L = i * F.G + F.vcu; if (L >= nun * GREP7) break; L %= nun; const int rt = L >> 2; int e = 0;
                for (int k = 1; k < 16; ++k) e += (rt >= tab[k]) ? 1 : 0;
                ul[4 + 4 * i] = rt; ul[5 + 4 * i] = L & 3; ul[6 + 4 * i] = e; ul[7 + 4 * i] = (rt - tab[e]) * 256; cnt_u = i + 1; }
            ul[0] = cnt_u; }
        __syncthreads();
    }
    if (IN(7)) _Pragma("nounroll") for (int rep_ = 0; rep_ < NREP7; ++rep_) {
        PHASE_IDS;
        pg8::MoeOrder S{tab + 64, (size_t)D * D, true};
        { const LAS int* ul = tab + 64; const int nun = ul[0];
          int tk[7];
#pragma unroll
          for (int j = 0; j < 7; ++j) { const int i = (tid >> 8) + 2 * j; tk[j] = 0;
              if (i < nun) { const int e = ul[6 + 4 * i], pos = ul[7 + 4 * i] + (tid & 255); if (pos < tab[32 + e]) tk[j] = LIST[e * NTOK + pos] >> 1; } }
#pragma unroll
          for (int j = 0; j < 7; ++j) { const int i = (tid >> 8) + 2 * j; if (i < nun) gtab[i * 256 + (tid & 255)] = tk[j]; } }
        __syncthreads();
        pg8::Gemm g{XN, WGU, D / 2, D / 2, D / 2, 127, 127};
        pg8::EpiAct E{(unsigned char*)ACT};
        pg8::gemm_phase<pg8::EpiAct, pg8::MoeOrder, true, true, true>(F.lds, g, S, E, gtab, tid);
        if (BOTH(7)) xcd_barrier(bar, opaque_tid(wave_s), cwarm, cjunk);
    }
    if (IN(8)) _Pragma("nounroll") for (int rep_ = 0; rep_ < NREP8; ++rep_) {
        PHASE_IDS;
        pg8::MoeOrder S{tab + 64, (size_t)D * DFF, false};
        pg8::Gemm g{ACT, WD, DFF / 2, DFF / 2, DFF / 2, 127, 127};
        pg8::EpiDown E{LIST, LW, tab, YB};
        pg8::gemm_phase<pg8::EpiDown, pg8::MoeOrder, true, false, true>(F.lds, g, S, E, nullptr, tid);
        if (BOTH(8)) xcd_barrier(bar, opaque_tid(wave_s), cwarm, cjunk);
    }
    if (IN(9)) _Pragma("nounroll") for (int rep_ = 0; rep_ < NREP9; ++rep_) {
        PHASE_IDS;
        for (int rb = F.vcu; rb < NTOK / 128; rb += F.G) {
        const int b = rb / 32;
        f32x4 g2[4], fg[4];
#pragma unroll
        for (int j = 0; j < 4; ++j) { const int k = 4 * lane + 256 * j; g2[j] = *(const f32x4*)(mod + b * NMOD * D + 5 * D + k); fg[j] = *(const f32x4*)(args.in[18] + k); }
        {
        v2u xv[4], nx[4]; unsigned ya[4], yb[4], na[4], nb[4];
        const unsigned char* Y8 = (const unsigned char*)YB;
        { const int m = rb * 128 + wave; const GAS v2u* xr = (const GAS v2u*)(X1B + (size_t)m * D) + lane;
          const GAS unsigned* y0 = (const GAS unsigned*)(Y8 + (size_t)m * D) + lane; const GAS unsigned* y1 = (const GAS unsigned*)(Y8 + (size_t)(NTOK + m) * D) + lane;
#pragma unroll
          for (int j = 0; j < 4; ++j) { xv[j] = xr[64 * j]; ya[j] = y0[64 * j]; yb[j] = y1[64 * j]; } }
        for (int r = wave; r < 128; r += NWAVES) {
            const int m = rb * 128 + r;
            if (r + NWAVES < 128) { const int m2 = m + NWAVES; const GAS v2u* xr = (const GAS v2u*)(X1B + (size_t)m2 * D) + lane;
                const GAS unsigned* y0 = (const GAS unsigned*)(Y8 + (size_t)m2 * D) + lane; const GAS unsigned* y1 = (const GAS unsigned*)(Y8 + (size_t)(NTOK + m2) * D) + lane;
#pragma unroll
                for (int j = 0; j < 4; ++j) { nx[j] = xr[64 * j]; na[j] = y0[64 * j]; nb[j] = y1[64 * j]; } }
            f32x4 v[4]; float ss = 0.f;
#pragma unroll
            for (int j = 0; j < 4; ++j) { typedef float f2_ __attribute__((ext_vector_type(2)));
                const f2_ a0 = __builtin_amdgcn_cvt_pk_f32_fp8((int)ya[j], false), a1 = __builtin_amdgcn_cvt_pk_f32_fp8((int)ya[j], true), c0 = __builtin_amdgcn_cvt_pk_f32_fp8((int)yb[j], false), c1 = __builtin_amdgcn_cvt_pk_f32_fp8((int)yb[j], true);
                const f32x4 ys = (f32x4){a0.x + c0.x, a0.y + c0.y, a1.x + c1.x, a1.y + c1.y} * 0.0625f;
                v[j] = (f32x4){bflo(xv[j].x), bfhi(xv[j].x), bflo(xv[j].y), bfhi(xv[j].y)} + g2[j] * ys; ss += (v[j].x * v[j].x + v[j].y * v[j].y) + (v[j].z * v[j].z + v[j].w * v[j].w); }
            const float rstd = 1.f / sqrtf(wave_sum(ss) * (1.f / D) + RMS_EPS);
            { GAS f32x4* dr = (GAS f32x4*)(args.out + (size_t)m * D) + lane;
#pragma unroll
              for (int j = 0; j < 4; ++j) dr[64 * j] = v[j] * rstd * fg[j]; }
#pragma unroll
            for (int j = 0; j < 4; ++j) { xv[j] = nx[j]; ya[j] = na[j]; yb[j] = nb[j]; }
        }
        }
        }
    }
#undef IN
#undef BOTH
}

extern "C" void kernel_launch(void* const* d_in, const int* in_sizes, int n_in, void* d_out, int out_size, void* d_ws, size_t ws_size, hipStream_t stream) {
    static int grid = 0;
    if (grid == 0) {
        if (n_in != 19 || in_sizes[0] != NTOK * D || out_size != NTOK * D || ws_size < WS_END) { fprintf(stderr, "kernel_launch: unexpected problem shape (n_in %d, ws %zu)\n", n_in, ws_size); grid = -1; return; }
        int dev = 0, cus = 0, per_cu = 0;
        if (hipGetDevice(&dev) != hipSuccess || hipDeviceGetAttribute(&cus, hipDeviceAttributeMultiprocessorCount, dev) != hipSuccess) { grid = -1; return; }
        if (hipFuncSetAttribute((const void*)fwd, hipFuncAttributeMaxDynamicSharedMemorySize, LDS_BYTES) != hipSuccess) { grid = -1; return; }
        if (hipOccupancyMaxActiveBlocksPerMultiprocessor(&per_cu, (const void*)fwd, NWAVES * 64, LDS_BYTES) != hipSuccess || per_cu < 1) { fprintf(stderr, "kernel_launch: occupancy query reports %d\n", per_cu); }
        (void)hipGetLastError();
        grid = cus;
    }
    if (grid < 0) return;
    if (hipMemsetAsync((char*)d_ws + WS_CTL, 0, CTL_ZERO_BYTES, stream) != hipSuccess) return;
    Args a{};
    for (int i = 0; i < 19; ++i) a.in[i] = (const float*)d_in[i];
    a.out = (float*)d_out; a.ws = (unsigned char*)d_ws; a.ph_lo = 0; a.ph_hi = 10;
    hipLaunchKernelGGL(fwd, dim3(grid), dim3(NWAVES * 64), LDS_BYTES, stream, a);
}
```

```cpp
#include <hip/hip_runtime.h>
#include <cstdio>
#include <cstdint>

#define GAS __attribute__((address_space(1)))
#define LAS __attribute__((address_space(3)))
typedef unsigned short bf16;
typedef unsigned v4u __attribute__((ext_vector_type(4)));
typedef unsigned v2u __attribute__((ext_vector_type(2)));
typedef float f32x4 __attribute__((ext_vector_type(4)));
typedef float f32x2 __attribute__((ext_vector_type(2)));
typedef short bf16x8 __attribute__((ext_vector_type(8)));

#define GREP2 1
#define GREP4 1
#define GREP5 1
#define GREP7 1
#define GREP8 1
#define PROBE_EPI 0
#define PROBE_ATT 0
#define PROBE_P1 0
#define NREP0 1
#define NREP1 1
#define NREP2 1
#define NREP3 1
#define NREP4 1
#define NREP5 1
#define NREP6 1
#define NREP7 1
#define NREP8 1
#define NREP9 1
constexpr int BATCH = 8, SEQ = 4096, D = 1024, NTOK = BATCH * SEQ, HD = 64;
constexpr int NIN = 5128, NP1 = 5120, NE = 16, DFF = 512, NMOD = 6;
constexpr float RMS_EPS = 1e-6f;
constexpr float LOG2E = 1.4426950408889634f;
constexpr float C2 = 0.125f * 1.4426950408889634f;
constexpr int NWAVES = 8;

constexpr size_t MiB = 1u << 20;
constexpr size_t WS_CTL = 0, CTL_ZERO_BYTES = 128 * 1024;
constexpr size_t WS_MOD = 1 * MiB;
constexpr size_t WS_LOGF = 1 * MiB + 256 * 1024;
constexpr size_t WS_F = 2 * MiB + 256 * 1024;
constexpr size_t WS_LIST = 4 * MiB;
constexpr size_t WS_LW = 6 * MiB;
constexpr size_t WS_WIN = 8 * MiB;
constexpr size_t WS_WBR = 18 * MiB;
constexpr size_t WS_WOUT = 20 * MiB;
constexpr size_t WS_WGU = 22 * MiB;
constexpr size_t WS_WD = 54 * MiB;
constexpr size_t WS_XN = 72 * MiB;
constexpr size_t WS_Q = 136 * MiB;
constexpr size_t WS_K = 200 * MiB;
constexpr size_t WS_V = 264 * MiB;
constexpr size_t WS_GA = 328 * MiB;
constexpr size_t WS_GB = 392 * MiB;
constexpr size_t WS_ACT = 136 * MiB;
constexpr size_t WS_Y = 328 * MiB;
constexpr size_t WS_XN8 = 456 * MiB;
constexpr size_t WS_WIN8 = 38 * MiB;
constexpr size_t WS_SSQ = 488 * MiB;
constexpr size_t WS_END = 490 * MiB;
constexpr int CW_BAR = 4096;
constexpr int CW_CNT = 16384;
constexpr int CW_MODCNT = 24576;
constexpr int CW_NORM = 8192 + 1024;
constexpr int CW_WEREADY = 24576 + 192;
constexpr int CW_ATT = 8192 + 512;
constexpr int CW_TILE = 8192;
constexpr int CW_WREADY = 24576 + 64;
static_assert((CW_WEREADY + 64) * 4 <= 128 * 1024, "control words inside the per-call memset");
constexpr int CW_KMAX = 20480;

constexpr int RING_BYTES = 131072;
constexpr int MISC_OFF = RING_BYTES;
constexpr int TAB_OFF = RING_BYTES + 1024;
constexpr int LDS_BYTES = 147456;

__device__ __forceinline__ unsigned f2bf(float f) { unsigned u = __builtin_bit_cast(unsigned, f); return (u + 0x7fffu + ((u >> 16) & 1u)) >> 16; }
__device__ __forceinline__ unsigned pk2(float lo, float hi) { typedef float f2_ __attribute__((ext_vector_type(2))); typedef __bf16 b2_ __attribute__((ext_vector_type(2))); f2_ v = {lo, hi}; b2_ b = __builtin_convertvector(v, b2_); return __builtin_bit_cast(unsigned, b); }
__device__ __forceinline__ float bflo(unsigned w) { return __builtin_bit_cast(float, w << 16); }
__device__ __forceinline__ float bfhi(unsigned w) { return __builtin_bit_cast(float, w & 0xffff0000u); }
#define LDS_WAIT() asm volatile("s_waitcnt lgkmcnt(0)" ::: "memory")
#define VM_WAIT() asm volatile("s_waitcnt vmcnt(0)" ::: "memory")

namespace pg8 {
#define PG8_LAS __attribute__((address_space(3)))
typedef unsigned short bf16_t;
typedef unsigned u32x4 __attribute__((ext_vector_type(4)));
constexpr int BM = 256, BK = 64, HALF = 128, HTB = HALF * BK * 2, STAGE_BYTES = 8 * HTB, NXCD = 8, WGM = 8;

__host__ __device__ __forceinline__ int lds_byte(int r, int c) { const int st = (r >> 4) * 2 + (c >> 5), rr = r & 15, cc = c & 31, ob = rr * 64 + cc * 2; return st * 1024 + (ob ^ (((ob >> 9) & 1) << 5)); }
__host__ __device__ __forceinline__ void stage_rc(int b, int& R, int& C) { const int st = b / 1024, sb = b % 1024, swz = sb ^ (((sb >> 9) & 1) << 5); R = (st >> 1) * 16 + swz / 64; C = (st & 1) * 32 + (swz % 64) / 2; }
__host__ __device__ __forceinline__ int perm32(int rho) { const int n = rho >> 4, i = rho & 15; return 8 * (i >> 2) + 4 * n + (i & 3); }

struct Unit { int pm, pn, e, row0; };
typedef int v4i32x __attribute__((ext_vector_type(4)));
struct Gemm { const bf16_t* A; const bf16_t* Bt; int K, lda, ldb; int sa, sb; };
typedef int v8i32 __attribute__((ext_vector_type(8)));
typedef int v4i32 __attribute__((ext_vector_type(4)));

struct StaticOrder {
    int nM, nN, nwg, G, c, reps;
    __device__ void init(int M, int N, int G_, int c_, int reps_ = 1) { nM = M / BM; nN = N / BM; nwg = nM * nN; G = G_; c = c_; reps = reps_; }
    __device__ __forceinline__ bool next(int i, Unit& u) const {
        long L = (long)i * G + c; if (L >= (long)nwg * reps) return false;
        u.e = (L >= nwg) ? 1 : 0;
        L %= nwg;
        int wgid = (int)L; { const int q = nwg / NXCD, r = nwg % NXCD, xcd = wgid % NXCD, off = wgid / NXCD; wgid = (xcd < r ? xcd * (q + 1) : r * (q + 1) + (xcd - r) * q) + off; }
        const int nig = WGM * nN, gid = wgid / nig, fm = gid * WGM, gsz = (nM - fm) < WGM ? (nM - fm) : WGM;
        u.pm = fm + ((wgid % nig) % gsz); u.pn = (wgid % nig) / gsz; u.row0 = (int)L; return true;
    }
    __device__ __forceinline__ const char* abase(const Gemm& g, const Unit& u) const { return (const char*)g.A + (size_t)u.pm * BM * g.lda * 2; }
    __device__ __forceinline__ const char* bbase(const Gemm& g, const Unit& u) const { return (const char*)g.Bt + (size_t)u.pn * BM * g.ldb * 2; }
    __device__ __forceinline__ bool counted() const { return false; }
    __device__ __forceinline__ void signal(const Unit&) const {}
    __device__ __forceinline__ void acquire(const Unit&, int, int) const {}
};
struct GateOrder {
    StaticOrder M;
    __device__ __forceinline__ bool next(int i, Unit& u) const { if (!M.next(i >> 1, u)) return false; u.pn += 4 * (i & 1); u.row0 = u.row0 * 2 + (i & 1); return true; }
    __device__ __forceinline__ const char* abase(const Gemm& g, const Unit& u) const { return (const char*)g.A + (size_t)u.pm * BM * g.lda * 2; }
    __device__ __forceinline__ const char* bbase(const Gemm& g, const Unit& u) const { return (const char*)g.Bt + (size_t)u.pn * BM * g.ldb * 2; }
    __device__ __forceinline__ bool counted() const { return false; }
    __device__ __forceinline__ void signal(const Unit&) const {}
    __device__ __forceinline__ void acquire(const Unit&, int, int) const {}
};
struct MoeOrder {
    const PG8_LAS int* ul; size_t estride; bool gatherA;
    unsigned* sig = nullptr; unsigned* wait = nullptr;
    __device__ __forceinline__ bool counted() const { return wait != nullptr; }
    __device__ __forceinline__ void signal(const Unit& u) const {
        if (sig != nullptr) {
            int l_; asm volatile("v_mbcnt_lo_u32_b32 %0, -1, 0\n\tv_mbcnt_hi_u32_b32 %0, -1, %0" : "=v"(l_));
            if (l_ == 0) (void)__hip_atomic_fetch_add(sig + u.pm, 1u, __ATOMIC_RELAXED, __HIP_MEMORY_SCOPE_AGENT); } }
    const PG8_LAS unsigned* okm = nullptr;
    __device__ __forceinline__ void acquire(const Unit& u, int tid, int i) const {
        if (wait != nullptr && tid == 0 && !((*okm >> i) & 1u)) { unsigned sp = 0; while (__hip_atomic_load(wait + u.pm, __ATOMIC_RELAXED, __HIP_MEMORY_SCOPE_AGENT) < 32u) { __builtin_amdgcn_s_sleep(1); if (++sp > (1u << 20)) break; } } }
    __device__ __forceinline__ bool next(int i, Unit& u) const {
        unsigned a0 = (unsigned)(size_t)ul; asm volatile("" : "+s"(a0));
        const int n = __builtin_amdgcn_readfirstlane(*(const PG8_LAS int*)(size_t)a0); if (i >= n) return false;
        const v4i32x q = *(const PG8_LAS v4i32x*)(size_t)(a0 + 16u + 16u * (unsigned)i);
        u.pm = __builtin_amdgcn_readfirstlane(q.x); u.pn = __builtin_amdgcn_readfirstlane(q.y); u.e = __builtin_amdgcn_readfirstlane(q.z); u.row0 = __builtin_amdgcn_readfirstlane(q.w); return true;
    }
    __device__ __forceinline__ const char* abase(const Gemm& g, const Unit& u) const { return gatherA ? (const char*)g.A : (const char*)g.A + (size_t)u.pm * BM * g.lda * 2; }
    __device__ __forceinline__ const char* bbase(const Gemm& g, const Unit& u) const { return (const char*)g.Bt + (size_t)u.e * estride + (size_t)u.pn * BM * g.ldb * 2; }
};

__device__ __forceinline__ unsigned cvt_pk_bf16(float lo, float hi) { typedef float f2_ __attribute__((ext_vector_type(2))); typedef __bf16 b2_ __attribute__((ext_vector_type(2))); f2_ v = {lo, hi}; b2_ b = __builtin_convertvector(v, b2_); return __builtin_bit_cast(unsigned, b); }

struct EpiSplit {
    static constexpr bool PERM = true, HAS_MID = false; static constexpr bool PERM16 = true;
    bf16_t* O; int ldc; int split_cols; size_t split_stride; float scale0; unsigned* kmax; float sall; bool sig;
    __device__ __forceinline__ void operator()(const f32x4 (&acc)[2][2][4][2], const Unit& u, int wr, int wc, int fr, int fq) const {
        const int rowt = u.pm * BM + wr * 64; int colt = u.pn * BM; bf16_t* base = O;
        float sc = sall; const int tsplit = colt / split_cols; { const int t = tsplit; base += (size_t)t * split_stride; colt -= t * split_cols; if (t == 0) sc *= scale0; }
        if (kmax != nullptr && tsplit == 1 && colt < 512) {
            float mxv = 0.f;
#pragma unroll
            for (int ai = 0; ai < 2; ++ai)
#pragma unroll
                for (int m = 0; m < 4; ++m) { float q = 0.f;
#pragma unroll
                    for (int bj = 0; bj < 2; ++bj) { const f32x4 a = acc[ai][bj][m][0], c = acc[ai][bj][m][1];
                        q += (a[0] * a[0] + a[1] * a[1]) + (a[2] * a[2] + a[3] * a[3]) + (c[0] * c[0] + c[1] * c[1]) + (c[2] * c[2] + c[3] * c[3]); }
                    q += __shfl_xor(q, 16); q += __shfl_xor(q, 32); mxv = fmaxf(mxv, q); }
            mxv = fmaxf(mxv, __shfl_xor(mxv, 1)); mxv = fmaxf(mxv, __shfl_xor(mxv, 2)); mxv = fmaxf(mxv, __shfl_xor(mxv, 4)); mxv = fmaxf(mxv, __shfl_xor(mxv, 8));
            if (fr == 0 && fq == 0) { const int head = (colt >> 6) + wc, b = (u.pm * BM) / SEQ;
                __hip_atomic_fetch_max(kmax + (b * 8 + head) * 2, __builtin_bit_cast(unsigned, mxv), __ATOMIC_RELAXED, __HIP_MEMORY_SCOPE_AGENT); }
        }
        const bool odd = (fr & 1) != 0;
        const int col0 = colt + wc * 64 + 16 * fq + (odd ? 8 : 0);
#pragma unroll
        for (int ai = 0; ai < 2; ++ai)
#pragma unroll
            for (int m = 0; m < 4; ++m) { bf16_t* rowp = base + (size_t)(rowt + ai * HALF + m * 16 + (fr & ~1)) * ldc + col0; u32x4 wv[2];
#pragma unroll
                for (int bj = 0; bj < 2; ++bj) { f32x4 v0 = acc[ai][bj][m][0] * sc, v1 = acc[ai][bj][m][1] * sc;
                    if (sig) {
#pragma unroll
                        for (int j = 0; j < 4; ++j) { v0[j] = __builtin_amdgcn_rcpf(1.f + __expf(-v0[j])); v1[j] = __builtin_amdgcn_rcpf(1.f + __expf(-v1[j])); } }
                    wv[bj].x = cvt_pk_bf16(v0[0], v0[1]); wv[bj].y = cvt_pk_bf16(v0[2], v0[3]); wv[bj].z = cvt_pk_bf16(v1[0], v1[1]); wv[bj].w = cvt_pk_bf16(v1[2], v1[3]); }
                u32x4 rcv;
#pragma unroll
                for (int d = 0; d < 4; ++d) { const unsigned snd = odd ? wv[0][d] : wv[1][d]; rcv[d] = (unsigned)__builtin_amdgcn_update_dpp(0, (int)snd, 0xB1, 0xf, 0xf, true); }
                u32x4 X, Y;
#pragma unroll
                for (int d = 0; d < 4; ++d) { X[d] = odd ? rcv[d] : wv[0][d]; Y[d] = odd ? wv[1][d] : rcv[d]; }
                *(u32x4*)rowp = X; *(u32x4*)(rowp + ldc) = Y; }
    }
    __device__ __forceinline__ void mid(f32x4 (&)[2][2][4][2], const Unit&, int, int, int, int) const {}
};
struct EpiGate8 {
    static constexpr bool PERM = true, HAS_MID = false; static constexpr bool PERM16 = true;
    unsigned char* G8; float scale;
    __device__ __forceinline__ void operator()(const f32x4 (&acc)[2][2][4][2], const Unit& u, int wr, int wc, int fr, int fq) const {
        unsigned char* base = G8 + (size_t)u.row0 * 65536 + (wr * 4 + wc) * 8192 + (fq * 16 + fr) * 16;
#pragma unroll
        for (int ai = 0; ai < 2; ++ai)
#pragma unroll
            for (int m = 0; m < 4; ++m) { unsigned w[2][2];
#pragma unroll
                for (int bj = 0; bj < 2; ++bj)
#pragma unroll
                    for (int n = 0; n < 2; ++n) { unsigned q[4];
#pragma unroll
                        for (int j = 0; j < 4; ++j) { const float sg = __builtin_amdgcn_rcpf(1.f + __expf(-acc[ai][bj][m][n][j] * scale)); q[j] = (unsigned)fminf(fmaxf(sg * 255.f + 0.5f, 1.f), 255.f); }
                        w[bj][n] = q[0] | (q[1] << 8) | (q[2] << 16) | (q[3] << 24); }
                *(u32x4*)(base + (ai * 4 + m) * 1024) = (u32x4){w[0][0], w[0][1], w[1][0], w[1][1]}; }
    }
    __device__ __forceinline__ void mid(f32x4 (&)[2][2][4][2], const Unit&, int, int, int, int) const {}
};
struct EpiMerge {
    static constexpr bool PERM = true, HAS_MID = true; static constexpr bool PERM16 = true;
    const unsigned char* G8; bf16_t* O;
    __device__ __forceinline__ void mid(f32x4 (&acc)[2][2][4][2], const Unit& u, int wr, int wc, int fr, int fq) const {
        if (PROBE_EPI && u.e) return;
        const unsigned char* sa = G8 + (size_t)u.row0 * 131072 + (wr * 4 + wc) * 8192 + (fq * 16 + fr) * 16;
        u32x4 ga[2][4], gb[2][4];
#pragma unroll
        for (int ai = 0; ai < 2; ++ai)
#pragma unroll
            for (int m = 0; m < 4; ++m) { ga[ai][m] = *(const u32x4*)(sa + (ai * 4 + m) * 1024); gb[ai][m] = *(const u32x4*)(sa + 65536 + (ai * 4 + m) * 1024); }
#pragma unroll
        for (int ai = 0; ai < 2; ++ai)
#pragma unroll
            for (int m = 0; m < 4; ++m)
#pragma unroll
                for (int bj = 0; bj < 2; ++bj)
#pragma unroll
                    for (int n = 0; n < 2; ++n) { const unsigned a = ga[ai][m][bj * 2 + n], b = gb[ai][m][bj * 2 + n]; f32x4 r;
#pragma unroll
                        for (int j = 0; j < 4; ++j) r[j] = (float)((a >> (8 * j)) & 255u) * __builtin_amdgcn_rcpf((float)((b >> (8 * j)) & 255u));
                        acc[ai][bj][m][n] = acc[ai][bj][m][n] * r; }
    }
    __device__ __forceinline__ void operator()(const f32x4 (&acc)[2][2][4][2], const Unit& u, int wr, int wc, int fr, int fq) const {
        if (PROBE_EPI && u.e) return;
        const bool odd = (fr & 1) != 0;
        const int rowt = u.pm * BM + wr * 64 + (fr & ~1), col0 = u.pn * BM + wc * 64 + 16 * fq + (odd ? 8 : 0);
        const unsigned char* sb = G8 + (size_t)u.row0 * 131072 + 65536 + (wr * 4 + wc) * 8192 + (fq * 16 + fr) * 16;
        u32x4 gb[2][4];
#pragma unroll
        for (int ai = 0; ai < 2; ++ai)
#pragma unroll
            for (int m = 0; m < 4; ++m) gb[ai][m] = *(const u32x4*)(sb + (ai * 4 + m) * 1024);
        asm volatile("" ::: "memory");
#pragma unroll
        for (int ai = 0; ai < 2; ++ai)
#pragma unroll
            for (int m = 0; m < 4; ++m) { const size_t ro = (size_t)(rowt + ai * HALF + m * 16) * D + col0; u32x4 wv[2];
#pragma unroll
                for (int bj = 0; bj < 2; ++bj) { f32x4 v[2];
#pragma unroll
                    for (int n = 0; n < 2; ++n) { const unsigned b = gb[ai][m][bj * 2 + n]; f32x4 sg;
#pragma unroll
                        for (int j = 0; j < 4; ++j) sg[j] = (float)((b >> (8 * j)) & 255u) * (1.f / 255.f);
                        v[n] = acc[ai][bj][m][n] * sg; }
                    wv[bj].x = cvt_pk_bf16(v[0][0], v[0][1]); wv[bj].y = cvt_pk_bf16(v[0][2], v[0][3]); wv[bj].z = cvt_pk_bf16(v[1][0], v[1][1]); wv[bj].w = cvt_pk_bf16(v[1][2], v[1][3]); }
                u32x4 X, Y;
#pragma unroll
                for (int d = 0; d < 4; ++d) { const unsigned snd = odd ? wv[0][d] : wv[1][d]; const unsigned rcv = (unsigned)__builtin_amdgcn_update_dpp(0, (int)snd, 0xB1, 0xf, 0xf, true);
                    X[d] = odd ? rcv : wv[0][d]; Y[d] = odd ? wv[1][d] : rcv; }
                *(u32x4*)(O + ro) = X; *(u32x4*)(O + ro + D) = Y; }
    }
};
struct EpiResid {
    static constexpr bool PERM = true, HAS_MID = false; static constexpr bool PERM16 = true;
    const float* X; const float* gate; bf16_t* O; float* SSQ;
    __device__ __forceinline__ void operator()(const f32x4 (&acc)[2][2][4][2], const Unit& u, int wr, int wc, int fr, int fq) const {
        if (PROBE_EPI && u.e) return;
        const int row0 = u.pm * BM + wr * 64 + fr, col0 = u.pn * BM + wc * 64 + 16 * fq; const int b = (u.pm * BM) / SEQ; const bool odd = (fr & 1) != 0;
        f32x4 gv[2][2];
#pragma unroll
        for (int bj = 0; bj < 2; ++bj)
#pragma unroll
            for (int n = 0; n < 2; ++n) gv[bj][n] = *(const f32x4*)(gate + (size_t)b * NMOD * D + col0 + bj * 8 + n * 4);
#pragma unroll
        for (int ai = 0; ai < 2; ++ai) {
            f32x4 xv[4][2][2];
#pragma unroll
            for (int m = 0; m < 4; ++m) { const size_t ro = (size_t)(row0 + ai * HALF + m * 16) * D + col0;
#pragma unroll
                for (int bj = 0; bj < 2; ++bj)
#pragma unroll
                    for (int n = 0; n < 2; ++n) xv[m][bj][n] = *(const f32x4*)(X + ro + bj * 8 + n * 4); }
            asm volatile("" ::: "memory");
#pragma unroll
            for (int m = 0; m < 4; ++m) { const size_t rs = (size_t)(row0 - (odd ? 1 : 0) + ai * HALF + m * 16) * D + col0 + (odd ? 8 : 0); float sq = 0.f; u32x4 wv[2];
#pragma unroll
                for (int bj = 0; bj < 2; ++bj) { const f32x4 o0 = xv[m][bj][0] + gv[bj][0] * acc[ai][bj][m][0], o1 = xv[m][bj][1] + gv[bj][1] * acc[ai][bj][m][1];
                    wv[bj].x = cvt_pk_bf16(o0[0], o0[1]); wv[bj].y = cvt_pk_bf16(o0[2], o0[3]); wv[bj].z = cvt_pk_bf16(o1[0], o1[1]); wv[bj].w = cvt_pk_bf16(o1[2], o1[3]);
                    sq += ((o0[0] * o0[0] + o0[1] * o0[1]) + (o0[2] * o0[2] + o0[3] * o0[3])) + ((o1[0] * o1[0] + o1[1] * o1[1]) + (o1[2] * o1[2] + o1[3] * o1[3])); }
                { u32x4 X_, Y_;
#pragma unroll
                  for (int d = 0; d < 4; ++d) { const unsigned snd = odd ? wv[0][d] : wv[1][d]; const unsigned rcv = (unsigned)__builtin_amdgcn_update_dpp(0, (int)snd, 0xB1, 0xf, 0xf, true);
                      X_[d] = odd ? rcv : wv[0][d]; Y_[d] = odd ? wv[1][d] : rcv; }
                  *(u32x4*)(O + rs) = X_; *(u32x4*)(O + rs + D) = Y_; }
                sq += __shfl_xor(sq, 16); sq += __shfl_xor(sq, 32);
                if (fq == 0) SSQ[(size_t)(row0 + ai * HALF + m * 16) * 16 + u.pn * 4 + wc] = sq; }
            asm volatile("" ::: "memory");
        }
    }
    __device__ __forceinline__ void mid(f32x4 (&)[2][2][4][2], const Unit&, int, int, int, int) const {}
};
struct EpiAct {
    static constexpr bool PERM = true, HAS_MID = false; static constexpr bool PERM16 = false;
    unsigned char* ACT;
    __device__ __forceinline__ void operator()(const f32x4 (&acc)[2][2][4][2], const Unit& u, int wr, int wc, int fr, int fq) const {
        const int row0 = u.pm * BM + wr * 64 + fr, col0 = u.pn * 128 + wc * 32 + 8 * fq;
#pragma unroll
        for (int ai = 0; ai < 2; ++ai)
#pragma unroll
            for (int m = 0; m < 4; ++m) { float a[8];
#pragma unroll
                for (int n = 0; n < 2; ++n)
#pragma unroll
                    for (int j = 0; j < 4; ++j) { const float gg = acc[ai][0][m][n][j] * 0.03125f, uu = acc[ai][1][m][n][j] * 0.03125f; a[4 * n + j] = gg * __builtin_amdgcn_rcpf(1.f + __expf(-gg)) * uu; }
                unsigned w0 = __builtin_amdgcn_cvt_pk_fp8_f32(a[0], a[1], 0, false); w0 = __builtin_amdgcn_cvt_pk_fp8_f32(a[2], a[3], w0, true);
                unsigned w1 = __builtin_amdgcn_cvt_pk_fp8_f32(a[4], a[5], 0, false); w1 = __builtin_amdgcn_cvt_pk_fp8_f32(a[6], a[7], w1, true);
                typedef unsigned u32x2 __attribute__((ext_vector_type(2)));
                *(u32x2*)(ACT + (size_t)(row0 + ai * HALF + m * 16) * DFF + col0) = (u32x2){w0, w1}; }
    }
    __device__ __forceinline__ void mid(f32x4 (&)[2][2][4][2], const Unit&, int, int, int, int) const {}
};
struct EpiDown {
    static constexpr bool PERM = true, HAS_MID = false; static constexpr bool PERM16 = true;
    const int* list; const float* lw; const PG8_LAS int* tab; bf16_t* Y;
    __device__ __forceinline__ void operator()(const f32x4 (&acc)[2][2][4][2], const Unit& u, int wr, int wc, int fr, int fq) const {
        const int cnt = __builtin_amdgcn_readfirstlane(tab[32 + u.e]), col0 = u.pn * BM + wc * 64 + 16 * fq;
        int ent[8]; float wt[8];
#pragma unroll
        for (int q = 0; q < 8; ++q) { const int pos = u.row0 + (q >> 2) * HALF + wr * 64 + (q & 3) * 16 + fr; const bool ok = pos < cnt;
            ent[q] = ok ? list[u.e * NTOK + pos] : -1; wt[q] = ok ? lw[u.e * NTOK + pos] : 0.f; }
        asm volatile("" ::: "memory");
#pragma unroll
        for (int ai = 0; ai < 2; ++ai)
#pragma unroll
            for (int m = 0; m < 4; ++m) { const int e_ = ent[ai * 4 + m]; const float w = wt[ai * 4 + m];
                if (e_ >= 0) {
                    unsigned char* dst = (unsigned char*)Y + ((size_t)(e_ & 1) * NTOK + (size_t)(e_ >> 1)) * D + col0;
                    unsigned wq[4];
#pragma unroll
                    for (int bj = 0; bj < 2; ++bj) { const f32x4 v0 = acc[ai][bj][m][0] * w, v1 = acc[ai][bj][m][1] * w;
                        unsigned w0 = __builtin_amdgcn_cvt_pk_fp8_f32(v0[0], v0[1], 0, false); w0 = __builtin_amdgcn_cvt_pk_fp8_f32(v0[2], v0[3], w0, true);
                        unsigned w1 = __builtin_amdgcn_cvt_pk_fp8_f32(v1[0], v1[1], 0, false); w1 = __builtin_amdgcn_cvt_pk_fp8_f32(v1[2], v1[3], w1, true);
                        wq[2 * bj] = w0; wq[2 * bj + 1] = w1; }
                    *(u32x4*)dst = (u32x4){wq[0], wq[1], wq[2], wq[3]}; }
                if (m & 1) asm volatile("" ::: "memory"); }
    }
    __device__ __forceinline__ void mid(f32x4 (&)[2][2][4][2], const Unit&, int, int, int, int) const {}
};

template <class Epi, class Sched, bool ALIGN_EPI, bool GATHER, bool FP8 = false>
__device__ __forceinline__ void gemm_phase(PG8_LAS unsigned char* lds, const Gemm g, const Sched& S, const Epi& E, const PG8_LAS int* gtab, const int tid) {
    const int wid = __builtin_amdgcn_readfirstlane(tid >> 6), lane = tid & 63, wr = wid >> 2, wc = wid & 3, fr = lane & 15, fq = lane >> 4;
    const int K = g.K, nt = K / BK;
    unsigned vA[2][2], voffB[2];
#pragma unroll
    for (int i = 0; i < 2; ++i) { int R, C; stage_rc(tid * 16 + i * 8192, R, C); const int Rb = Epi::PERM16 ? (64 * (R >> 5) + 16 * ((R >> 2) & 3) + 4 * ((R >> 4) & 1) + (R & 3)) : Epi::PERM ? ((R & ~31) + perm32(R & 31)) : R;
        voffB[i] = (unsigned)(Rb * g.ldb + C) * 2u; vA[0][i] = (unsigned)(R * g.lda + C) * 2u; vA[1][i] = (unsigned)((R + HALF) * g.lda + C) * 2u; }
    const size_t kstep = (size_t)(BK * 2);
    const size_t hstepB = (size_t)(Epi::PERM16 ? 8 : HALF) * g.ldb * 2;
    const unsigned ldsw = (unsigned)wid * 1024u;
    const int aoff = lds_byte(wr * 64 + fr, fq * 8), boff = lds_byte(wc * 32 + fr, fq * 8);
    const int aoff0 = lds_byte(wr * 64 + fr, fq * 16), boff0 = lds_byte(wc * 32 + fr, fq * 16);
#define PG8_SA(b, h) (((b) * 2 + (h)) * HTB)
#define PG8_SB(b, h) ((4 + (b) * 2 + (h)) * HTB)
#define PG8_STAGE2(bufoff, gbase, o0, o1) do { unsigned o0_ = (o0), o1_ = (o1); if constexpr (FP8) asm volatile("" : "+v"(o0_), "+v"(o1_));     \
        __builtin_amdgcn_global_load_lds((const unsigned*)((const char*)(gbase) + o0_), (PG8_LAS unsigned*)(lds + (bufoff) + ldsw), 16, 0, 0); \
        __builtin_amdgcn_global_load_lds((const unsigned*)((const char*)(gbase) + o1_), (PG8_LAS unsigned*)(lds + (bufoff) + ldsw + 8192), 16, 0, 0); } while (0)
#define PG8_STAGE_B(bufoff, gbase) PG8_STAGE2(bufoff, gbase, voffB[0], voffB[1])
#define PG8_STAGE_A(bufoff, gbase, h) PG8_STAGE2(bufoff, gbase, vA[h][0], vA[h][1])
#define PG8_STAGE_AX(bufoff, gbase, h) PG8_STAGE2(bufoff, gbase, vA[h][0], vA[h][1])
#define PG8_LDA8(dst, b, h) do { _Pragma("unroll") for (int m = 0; m < 4; ++m) { const v4i32 c0_ = *(const PG8_LAS v4i32*)(lds + PG8_SA(b, h) + aoff0 + m * 2048), c1_ = *(const PG8_LAS v4i32*)(lds + PG8_SA(b, h) + aoff0 + m * 2048 + 16); \
        dst[m] = __builtin_shufflevector(c0_, c1_, 0, 1, 2, 3, 4, 5, 6, 7); } } while (0)
#define PG8_LDB8(dst, b, h) do { _Pragma("unroll") for (int n = 0; n < 2; ++n) { const v4i32 c0_ = *(const PG8_LAS v4i32*)(lds + PG8_SB(b, h) + boff0 + n * 2048), c1_ = *(const PG8_LAS v4i32*)(lds + PG8_SB(b, h) + boff0 + n * 2048 + 16); \
        dst[n] = __builtin_shufflevector(c0_, c1_, 0, 1, 2, 3, 4, 5, 6, 7); } } while (0)
#define PG8_MMA8(ai, bj, At, Bt) do { __builtin_amdgcn_s_setprio(1); _Pragma("unroll") for (int m = 0; m < 4; ++m) _Pragma("unroll") for (int n = 0; n < 2; ++n) \
        acc[ai][bj][m][n] = __builtin_amdgcn_mfma_scale_f32_16x16x128_f8f6f4(Bt[n], At[m], acc[ai][bj][m][n], 0, 0, 0, 127, 0, 127); __builtin_amdgcn_s_setprio(0); } while (0)
#define PG8_LDA(dst, b, h) do { _Pragma("unroll") for (int m = 0; m < 4; ++m) _Pragma("unroll") for (int k = 0; k < 2; ++k) dst[m][k] = *(const PG8_LAS bf16x8*)(lds + PG8_SA(b, h) + aoff + m * 2048 + k * 1024); } while (0)
#define PG8_LDB(dst, b, h) do { _Pragma("unroll") for (int n = 0; n < 2; ++n) _Pragma("unroll") for (int k = 0; k < 2; ++k) dst[n][k] = *(const PG8_LAS bf16x8*)(lds + PG8_SB(b, h) + boff + n * 2048 + k * 1024); } while (0)
#define PG8_MMA(ai, bj, At, Bt) do { __builtin_amdgcn_s_setprio(1); _Pragma("unroll") for (int m = 0; m < 4; ++m) _Pragma("unroll") for (int n = 0; n < 2; ++n) _Pragma("unroll") for (int k = 0; k < 2; ++k) \
        acc[ai][bj][m][n] = __builtin_amdgcn_mfma_f32_16x16x32_bf16(Bt[n][k], At[m][k], acc[ai][bj][m][n], 0, 0, 0); __builtin_amdgcn_s_setprio(0); } while (0)
#define PG8_WAIT_V(n) asm volatile("s_waitcnt vmcnt(" #n ")" ::: "memory")
#define PG8_WAIT_L(n) asm volatile("s_waitcnt lgkmcnt(" #n ")" ::: "memory")
#define PG8_BAR __builtin_amdgcn_s_barrier()
#define PG8_SCHED __builtin_amdgcn_sched_barrier(0)
    Unit cur, nxt, prv; int ui = 0;
    if (!S.next(0, cur)) return;
    if (S.counted()) { S.acquire(cur, tid, 0); PG8_BAR; }
    if constexpr (GATHER) {
#pragma unroll
        for (int h = 0; h < 2; ++h)
#pragma unroll
            for (int i = 0; i < 2; ++i) { int R, C; stage_rc(tid * 16 + i * 8192, R, C); vA[h][i] = (unsigned)gtab[R + h * HALF] * (unsigned)(g.lda * 2) + (unsigned)C * 2u; }
    }
    f32x4 acc[2][2][4][2];
#pragma unroll
    for (int a = 0; a < 2; ++a)
#pragma unroll
        for (int b = 0; b < 2; ++b)
#pragma unroll
            for (int m = 0; m < 4; ++m)
#pragma unroll
                for (int n = 0; n < 2; ++n) acc[a][b][m][n] = (f32x4){0.f, 0.f, 0.f, 0.f};
    bf16x8 At[4][2], B0[2][2], B1[2][2]; v8i32 At8[4], B08[2], B18[2];
    const char* cA = S.abase(g, cur); const char* cB = S.bbase(g, cur);
    PG8_STAGE_B(PG8_SB(0, 0), cB); PG8_STAGE_B(PG8_SB(0, 1), cB + hstepB); PG8_STAGE_A(PG8_SA(0, 0), cA, 0); PG8_STAGE_A(PG8_SA(0, 1), cA, 1);
    if (wr == 1) PG8_BAR;
    PG8_WAIT_V(2); PG8_BAR;
    PG8_STAGE_B(PG8_SB(1, 0), cB + kstep); PG8_STAGE_A(PG8_SA(1, 0), cA + kstep, 0); PG8_STAGE_B(PG8_SB(1, 1), cB + hstepB + kstep);
    PG8_WAIT_V(6); PG8_BAR;
    for (;;) {
        const bool has_next = S.next(ui + 1, nxt);
        if (has_next) S.acquire(nxt, tid, ui + 1);
        const char* nA = has_next ? S.abase(g, nxt) : cA; const char* nB = has_next ? S.bbase(g, nxt) : cB;
        _Pragma("nounroll") for (int t = 0; t < nt; t += 2) {
            const bool last = (t == nt - 2);
            if constexpr (Epi::HAS_MID) { if (t == (nt >> 1)) { int ln_e; asm volatile("v_mbcnt_lo_u32_b32 %0, -1, 0\n\tv_mbcnt_hi_u32_b32 %0, -1, %0" : "=v"(ln_e)); E.mid(acc, cur, wr, wc, ln_e & 15, ln_e >> 4); } }
            const char* a1 = cA + (size_t)(t + 1) * kstep;
            const char* a2 = last ? nA : cA + (size_t)(t + 2) * kstep; const char* b2 = last ? nB : cB + (size_t)(t + 2) * kstep;
            const char* a3 = a2 + kstep; const char* b3 = b2 + kstep;

            if constexpr (FP8) { PG8_LDB8(B08, 0, 0); PG8_LDB8(B18, 0, 1); PG8_SCHED; PG8_LDA8(At8, 0, 0); } else { PG8_LDB(B0, 0, 0); PG8_LDB(B1, 0, 1); PG8_SCHED; PG8_LDA(At, 0, 0); } PG8_STAGE_A(PG8_SA(1, 1), a1, 1);
            if constexpr (GATHER) { if (last && has_next) {
#pragma unroll
                for (int h = 0; h < 2; ++h)
#pragma unroll
                    for (int i = 0; i < 2; ++i) { int R, C; stage_rc(tid * 16 + i * 8192, R, C); vA[h][i] = (unsigned)gtab[(ui + 1) * BM + R + h * HALF] * (unsigned)(g.lda * 2) + (unsigned)C * 2u; } } }
            PG8_WAIT_V(8); PG8_WAIT_L(0); PG8_BAR; if constexpr (FP8) { PG8_MMA8(0, 0, At8, B08); PG8_MMA8(0, 1, At8, B18); } else { PG8_MMA(0, 0, At, B0); PG8_MMA(0, 1, At, B1); } PG8_BAR; PG8_SCHED;
            if constexpr (FP8) { PG8_LDA8(At8, 0, 1); } else { PG8_LDA(At, 0, 1); } PG8_STAGE_B(PG8_SB(0, 0), b2); PG8_STAGE_B(PG8_SB(0, 1), b2 + hstepB); PG8_STAGE_AX(PG8_SA(0, 0), a2, 0);
            PG8_WAIT_V(8); PG8_WAIT_L(0); PG8_BAR; if constexpr (FP8) { PG8_MMA8(1, 0, At8, B08); PG8_MMA8(1, 1, At8, B18); } else { PG8_MMA(1, 0, At, B0); PG8_MMA(1, 1, At, B1); } PG8_BAR; PG8_SCHED;
            if constexpr (FP8) { PG8_LDB8(B08, 1, 0); PG8_LDB8(B18, 1, 1); PG8_SCHED; PG8_LDA8(At8, 1, 0); } else { PG8_LDB(B0, 1, 0); PG8_LDB(B1, 1, 1); PG8_SCHED; PG8_LDA(At, 1, 0); } PG8_STAGE_AX(PG8_SA(0, 1), a2, 1);
            PG8_WAIT_V(8); PG8_WAIT_L(0); PG8_BAR; if constexpr (FP8) { PG8_MMA8(0, 0, At8, B08); PG8_MMA8(0, 1, At8, B18); } else { PG8_MMA(0, 0, At, B0); PG8_MMA(0, 1, At, B1); } PG8_BAR; PG8_SCHED;
            if constexpr (FP8) { PG8_LDA8(At8, 1, 1); } else { PG8_LDA(At, 1, 1); } PG8_STAGE_B(PG8_SB(1, 0), b3); PG8_STAGE_B(PG8_SB(1, 1), b3 + hstepB); PG8_STAGE_AX(PG8_SA(1, 0), a3, 0);
            PG8_WAIT_V(8); PG8_WAIT_L(0); PG8_BAR; if constexpr (FP8) { PG8_MMA8(1, 0, At8, B08); PG8_MMA8(1, 1, At8, B18); } else { PG8_MMA(1, 0, At, B0); PG8_MMA(1, 1, At, B1); } PG8_BAR; PG8_SCHED;
        }
        if constexpr (ALIGN_EPI) { if (wr == 0) PG8_BAR; }
        if (ui > 0) S.signal(prv);
        { int ln_e; asm volatile("v_mbcnt_lo_u32_b32 %0, -1, 0\n\tv_mbcnt_hi_u32_b32 %0, -1, %0" : "=v"(ln_e)); E(acc, cur, wr, wc, ln_e & 15, ln_e >> 4); }
        if (!has_next) break;
#pragma unroll
        for (int a = 0; a < 2; ++a)
#pragma unroll
            for (int b = 0; b < 2; ++b)
#pragma unroll
                for (int m = 0; m < 4; ++m)
#pragma unroll
                    for (int n = 0; n < 2; ++n) acc[a][b][m][n] = (f32x4){0.f, 0.f, 0.f, 0.f};
        prv = cur; cur = nxt; cA = nA; cB = nB; ++ui;
        if constexpr (ALIGN_EPI) { if (wr == 1) PG8_BAR; }
    }
    PG8_WAIT_V(0);
    S.signal(cur);
    if constexpr (!ALIGN_EPI) { if (wr == 0) PG8_BAR; }
    PG8_BAR;
#undef PG8_SA
#undef PG8_SB
#undef PG8_STAGE2
#undef PG8_STAGE_A
#undef PG8_STAGE_AX
#undef PG8_STAGE_B
#undef PG8_LDA
#undef PG8_LDA8
#undef PG8_LDB8
#undef PG8_MMA8
#undef PG8_LDB
#undef PG8_MMA
#undef PG8_WAIT_V
#undef PG8_WAIT_L
#undef PG8_BAR
#undef PG8_SCHED
}
}

#define XB_TMO      128
#define XB_XCNT(j)  (256  + 64 * (j))
#define XB_XSUB(j)  (1280 + 64 * (j))
#define XB_XGEN(j)  (2304 + 64 * (j))
#define XB_TOP      3328
#define XB_TOPGEN   3392
#define XCD_BAR_WORDS 3456
#define XB_SPIN_CAP (1u << 18)

__device__ __forceinline__ unsigned xb_ld(unsigned* p)              { return __hip_atomic_load(p, __ATOMIC_RELAXED, __HIP_MEMORY_SCOPE_AGENT); }
__device__ __forceinline__ unsigned xb_add(unsigned* p, unsigned v) { return __hip_atomic_fetch_add(p, v, __ATOMIC_RELAXED, __HIP_MEMORY_SCOPE_AGENT); }
__device__ __forceinline__ unsigned xb_xcc_id() { return (unsigned)__builtin_amdgcn_s_getreg((3 << 11) | 20) & 0xFu; }
#define XB_SPIN(cond, bar) do { unsigned _sp = 0; while (cond) { __builtin_amdgcn_s_sleep(1); \
    if ((++_sp & 255u) == 0u) { if (xb_ld(&(bar)[XB_TMO])) break; if (_sp > XB_SPIN_CAP) { atomicAdd(&(bar)[XB_TMO], 1u); break; } } } } while (0)

struct XcdBarrier { unsigned* bar; unsigned x; volatile LAS unsigned* st; };

__device__ __forceinline__ XcdBarrier xcd_barrier_post(unsigned* bar, volatile LAS unsigned* st, int tid_) {
    XcdBarrier b; b.bar = bar; b.x = xb_xcc_id(); b.st = st;
    if (tid_ == 0) st[3] = xb_add(&bar[XB_XCNT(b.x)], 1u);
    return b;
}
__device__ __forceinline__ void xcd_barrier_complete(unsigned* bar, unsigned x, unsigned& nloc, unsigned& nx, unsigned& bal) {
    const unsigned G = gridDim.x * gridDim.y * gridDim.z;
    unsigned sum, cnt, mine, sp = 0u;
    for (;;) {
        sum = 0u; cnt = 0u; mine = 0u; bal = 1u;
#pragma unroll
        for (unsigned j = 0; j < 16; ++j) { const unsigned c = xb_ld(&bar[XB_XCNT(j)]); sum += c; cnt += (c > 0u) ? 1u : 0u; mine = (j == x) ? c : mine; if (c != ((j < 8u) ? G / 8u : 0u)) bal = 0u; }
        if (sum == G) break;
        __builtin_amdgcn_s_sleep(1);
        if ((++sp & 255u) == 0u) { if (xb_ld(&bar[XB_TMO])) break; if (sp > XB_SPIN_CAP) { atomicAdd(&bar[XB_TMO], 1u); break; } }
    }
    nloc = mine > 0u ? mine : 1u; nx = cnt > 0u ? cnt : 1u;
}
__device__ __forceinline__ void xcd_barrier(const XcdBarrier& b, int tid_, const unsigned char* warm = nullptr, LAS unsigned char* junk = nullptr, bool release = true) {
    asm volatile("s_waitcnt vmcnt(0)" ::: "memory");
    __syncthreads();
    if (warm != nullptr && (tid_ >> 6) == 7) { const int l_ = tid_ & 63; if (l_ < 38) __builtin_amdgcn_global_load_lds((const unsigned*)(warm + l_ * 128), (LAS unsigned*)junk, 4, 0, 0); }
    if (tid_ == 0) {
        unsigned* bar = b.bar; const unsigned G_ = gridDim.x;
        __builtin_amdgcn_s_waitcnt(0);
        unsigned nloc = b.st[0], nx = b.st[1];
        if (nloc == 0u) { unsigned bal; xcd_barrier_complete(bar, b.x, nloc, nx, bal); b.st[0] = nloc; b.st[1] = nx; b.st[2] = ((G_ & 7u) == 0u) ? bal : 0u; }
        __builtin_amdgcn_fence(__ATOMIC_ACQUIRE, "agent");
        asm volatile("s_waitcnt vmcnt(0)" ::: "memory");
        const unsigned old = xb_add(&bar[XB_XSUB(b.x)], 1u);
        const unsigned gen = old / nloc;
        if (old + 1u == (gen + 1u) * nloc) {
            if (release) { __builtin_amdgcn_fence(__ATOMIC_RELEASE, "agent"); asm volatile("s_waitcnt vmcnt(0)" ::: "memory"); }
            const unsigned og = xb_add(&bar[XB_TOP], 1u);
            const unsigned tg = og / nx;
            if (og + 1u == (tg + 1u) * nx) xb_add(&bar[XB_TOPGEN], 1u);
            else XB_SPIN(xb_ld(&bar[XB_TOPGEN]) == tg, bar);
            xb_add(&bar[XB_XGEN(b.x)], 1u);
            asm volatile("s_waitcnt vmcnt(0)" ::: "memory");
        } else {
            XB_SPIN(xb_ld(&bar[XB_XGEN(b.x)]) == gen, bar);
        }
    }
    __syncthreads();
}
__device__ __forceinline__ void xcd_census(const XcdBarrier& b) {
    unsigned nloc = b.st[0], nx = b.st[1];
    if (nloc == 0u) { unsigned bal; xcd_barrier_complete(b.bar, b.x, nloc, nx, bal); b.st[0] = nloc; b.st[1] = nx; b.st[2] = ((gridDim.x & 7u) == 0u) ? bal : 0u; }
}
__device__ __forceinline__ void xcd_barrier_local(const XcdBarrier& b, int tid_, const unsigned char* warm = nullptr, LAS unsigned char* junk = nullptr) {
    asm volatile("s_waitcnt vmcnt(0)" ::: "memory");
    __syncthreads();
    if (warm != nullptr && (tid_ >> 6) == 7) { const int l_ = tid_ & 63; if (l_ < 38) __builtin_amdgcn_global_load_lds((const unsigned*)(warm + l_ * 128), (LAS unsigned*)junk, 4, 0, 0); }
    if (tid_ == 0) {
        unsigned* bar = b.bar;
        __builtin_amdgcn_s_waitcnt(0);
        const unsigned nloc = b.st[0];
        __builtin_amdgcn_fence(__ATOMIC_ACQUIRE, "agent");
        asm volatile("s_waitcnt vmcnt(0)" ::: "memory");
        const unsigned old = xb_add(&bar[XB_XSUB(b.x)], 1u);
        const unsigned gen = old / nloc;
        if (old + 1u == (gen + 1u) * nloc) { xb_add(&bar[XB_XGEN(b.x)], 1u); asm volatile("s_waitcnt vmcnt(0)" ::: "memory"); }
        else XB_SPIN(xb_ld(&bar[XB_XGEN(b.x)]) == gen, bar);
    }
    __syncthreads();
}


namespace att {
typedef float f32x16 __attribute__((ext_vector_type(16)));
typedef short v4i16_t __attribute__((ext_vector_type(4)));
constexpr float ATT_THR = 16.f;
__device__ __forceinline__ int crow(int r, int hi) { return (r & 3) + 8 * (r >> 2) + 4 * hi; }
__device__ __forceinline__ unsigned cvtpk(float lo, float hi) { typedef float f2 __attribute__((ext_vector_type(2))); typedef __bf16 b2 __attribute__((ext_vector_type(2))); f2 v = {lo, hi}; b2 b = __builtin_convertvector(v, b2); return __builtin_bit_cast(unsigned, b); }
__device__ __forceinline__ bf16x8 pack8(const f32x16& p, int b0) { v4u w; w.x = cvtpk(p[b0], p[b0 + 1]); w.y = cvtpk(p[b0 + 2], p[b0 + 3]); w.z = cvtpk(p[b0 + 4], p[b0 + 5]); w.w = cvtpk(p[b0 + 6], p[b0 + 7]); return __builtin_bit_cast(bf16x8, w); }

__device__ __forceinline__ void glds16(const void* gsrc, unsigned lds_dst) { unsigned keep;
    asm volatile("s_mov_b32 %0, m0\n\ts_mov_b32 m0, %2\n\ts_nop 0\n\tglobal_load_lds_dwordx4 %1, off\n\ts_mov_b32 m0, %0" : "=&s"(keep) : "v"(gsrc), "s"(lds_dst) : "memory"); }
template <bool SB>
__device__ __forceinline__ void attn_wave(int b, int hc, int q0, const bf16* Q, const bf16* K, const bf16* V, bf16* O, const float* Frow, float bk2, LAS unsigned char* vlds, int lane) {
    const int r32 = lane & 31, hi = lane >> 5;
    const size_t rowb = (size_t)b * SEQ;
    const bf16* Kh = K + rowb * D + hc; const bf16* Vh = V + rowb * D + hc;
    bf16x8 qr[4];
#pragma unroll
    for (int d0 = 0; d0 < 4; ++d0) qr[d0] = *(const bf16x8*)(Q + (rowb + q0 + r32) * D + hc + 16 * d0 + 8 * hi);
    const bf16* ksrc = Kh + (size_t)r32 * D + 8 * hi;
    const bf16* vsrc = Vh + (size_t)(lane >> 2) * D + (lane & 3) * 8;
    LAS unsigned char* vw = vlds + lane * 16;
    LAS unsigned char* vrd = vlds + ((lane >> 4) & 1) * 32 + (lane & 3) * 8 + (4 * hi + ((lane & 15) >> 2)) * 64;
    const int td = q0 >> 6, qabs = q0 + r32;
    float carry = 0.f; bf16x8 T0, T1;
    if constexpr (SB) {
        v4u a, c;
#pragma unroll
        for (int w = 0; w < 4; ++w) { unsigned lo, hi2;
            { const int jj = 2 * w; const int j0 = 8 * (jj >> 2) + 4 * hi + (jj & 3), j1 = j0 + 1;
              lo = ((j0 > r32) ? 0x3F80u : 0u) | ((j1 > r32) ? 0x3F800000u : 0u); hi2 = ((16 + j0 > r32) ? 0x3F80u : 0u) | ((16 + j1 > r32) ? 0x3F800000u : 0u); }
            a[w] = lo; c[w] = hi2; }
        T0 = __builtin_bit_cast(bf16x8, a); T1 = __builtin_bit_cast(bf16x8, c);
    }
    bf16x8 kf[8]; v4u vst[8];
#define ATT_LOADK(t_) do { _Pragma("unroll") for (int d0 = 0; d0 < 4; ++d0) { kf[2 * d0] = *(const bf16x8*)(ksrc + (size_t)((t_) * 64) * D + 16 * d0); kf[2 * d0 + 1] = *(const bf16x8*)(ksrc + (size_t)((t_) * 64 + 32) * D + 16 * d0); } } while (0)
#define ATT_LOADV(t_) do { _Pragma("unroll") for (int p = 0; p < 8; ++p) vst[p] = *(const v4u*)(vsrc + (size_t)((t_) * 64 + 16 * (p & 3)) * D + 32 * (p >> 2)); } while (0)
#define ATT_WRITEV(sl_) do { _Pragma("unroll") for (int p = 0; p < 8; ++p) *(LAS v4u*)(vw + (sl_) * 8192 + p * 1024) = vst[p]; } while (0)
    int t = td; constexpr int slot = 0;
    LAS float* fwin = (LAS float*)(vlds + 8192);
    const int tw0 = (td > 31) ? td - 31 : 0, wk0 = tw0 * 64;
    ATT_LOADK(t); ATT_LOADV(t);
    if constexpr (!SB) {
        f32x4 fw[8];
#pragma unroll
        for (int i = 0; i < 8; ++i) { const int key = wk0 + 4 * lane + 256 * i; fw[i] = (key < td * 64 + 64) ? *(const f32x4*)(Frow + key) : (f32x4){0.f, 0.f, 0.f, 0.f}; }
#pragma unroll
        for (int i = 0; i < 8; ++i) *(LAS f32x4*)(fwin + 4 * lane + 256 * i) = fw[i];
    }
    ATT_WRITEV(0);
    f32x16 o[2];
#pragma unroll
    for (int r = 0; r < 16; ++r) { o[0][r] = 0.f; o[1][r] = 0.f; }
    float m = -INFINITY, l = 0.f, FrL = 0.f, bqbk = 0.f;
    if constexpr (!SB) {
        FrL = Frow[q0] * LOG2E;
        float qs = 0.f;
#pragma unroll
        for (int d0 = 0; d0 < 4; ++d0) { const v4u w = __builtin_bit_cast(v4u, qr[d0]);
#pragma unroll
            for (int e = 0; e < 4; ++e) { const float x0 = bflo(w[e]), x1 = bfhi(w[e]); qs += x0 * x0 + x1 * x1; } }
        qs += __shfl_xor(qs, 32);
#pragma unroll
        for (int off = 1; off < 32; off <<= 1) qs = fmaxf(qs, __shfl_xor(qs, off));
        bqbk = sqrtf(qs * bk2) * 1.02f + 0.01f;
    }
    for (;;) {
        const int kv0 = t * 64; const bool more = t > 0, diag = (t == td);
        if constexpr (!SB) { if (more) ATT_LOADV(t - 1); }
        f32x16 p0, p1;
        if constexpr (SB) {
#pragma unroll
            for (int r = 0; r < 16; ++r) { p0[r] = 0.f; p1[r] = 0.f; }
        } else {
#pragma unroll
            for (int g = 0; g < 4; ++g) { f32x4 fa, fb;
                if (t >= tw0) { fa = *(const LAS f32x4*)(fwin + (kv0 - wk0) + 8 * g + 4 * hi); fb = *(const LAS f32x4*)(fwin + (kv0 - wk0) + 32 + 8 * g + 4 * hi); }
                else { fa = *(const f32x4*)(Frow + kv0 + 8 * g + 4 * hi); fb = *(const f32x4*)(Frow + kv0 + 32 + 8 * g + 4 * hi); }
#pragma unroll
                for (int c = 0; c < 4; ++c) { p0[4 * g + c] = __builtin_fmaf(fa[c], -LOG2E, FrL); p1[4 * g + c] = __builtin_fmaf(fb[c], -LOG2E, FrL); } }
        }
#pragma unroll
        for (int d0 = 0; d0 < 4; ++d0) { p0 = __builtin_amdgcn_mfma_f32_32x32x16_bf16(kf[2 * d0], qr[d0], p0, 0, 0, 0); p1 = __builtin_amdgcn_mfma_f32_32x32x16_bf16(kf[2 * d0 + 1], qr[d0], p1, 0, 0, 0); }
        if (more) ATT_LOADK(t - 1);
        bf16x8 pw[4];
        if constexpr (SB) {
            f32x16 lb0, lb1;
            float rt0 = 0.f, rt1 = 0.f;
#pragma unroll
            for (int r = 0; r < 16; ++r) {
                { const float z = p0[r], lg = __builtin_amdgcn_logf(1.f + __builtin_amdgcn_exp2f(-fabsf(z))); const float lbv = fminf(z, 0.f) - lg; float lm = lbv - z;
                  const bool valid = !diag || (kv0 + crow(r, hi) < qabs); lm = valid ? lm : 0.f; lb0[r] = valid ? lbv : -INFINITY; p0[r] = lm; rt0 += lm; }
                { const float z = p1[r], lg = __builtin_amdgcn_logf(1.f + __builtin_amdgcn_exp2f(-fabsf(z))); const float lbv = fminf(z, 0.f) - lg; float lm = lbv - z;
                  const bool valid = !diag || (kv0 + 32 + crow(r, hi) < qabs); lm = valid ? lm : 0.f; lb1[r] = valid ? lbv : -INFINITY; p1[r] = lm; rt1 += lm; }
            }
            rt0 += __shfl_xor(rt0, 32); rt1 += __shfl_xor(rt1, 32);
            const bf16x8 m0 = pack8(p0, 0), m1 = pack8(p0, 8), m2 = pack8(p1, 0), m3 = pack8(p1, 8);
            { const float c0_ = carry + rt1;
#pragma unroll
              for (int r = 0; r < 16; ++r) { lb0[r] += c0_; lb1[r] += carry; } }
            lb0 = __builtin_amdgcn_mfma_f32_32x32x16_bf16(T0, m0, lb0, 0, 0, 0); lb0 = __builtin_amdgcn_mfma_f32_32x32x16_bf16(T1, m1, lb0, 0, 0, 0);
            lb1 = __builtin_amdgcn_mfma_f32_32x32x16_bf16(T0, m2, lb1, 0, 0, 0); lb1 = __builtin_amdgcn_mfma_f32_32x32x16_bf16(T1, m3, lb1, 0, 0, 0);
#pragma unroll
            for (int r = 0; r < 16; ++r) { p0[r] = __builtin_amdgcn_exp2f(lb0[r]); p1[r] = __builtin_amdgcn_exp2f(lb1[r]); }
            carry += rt0 + rt1;
        } else {
            if (diag) {
#pragma unroll
                for (int r = 0; r < 16; ++r) { if (kv0 + crow(r, hi) > qabs) p0[r] = -INFINITY; if (kv0 + 32 + crow(r, hi) > qabs) p1[r] = -INFINITY; }
            }
            float mx = fmaxf(p0[0], p1[0]);
#pragma unroll
            for (int r = 1; r < 16; ++r) mx = fmaxf(mx, fmaxf(p0[r], p1[r]));
            mx = fmaxf(mx, __shfl_xor(mx, 32));
            const float mnew = fmaxf(m, mx);
            if (__any(mnew > m)) { const float sc = __builtin_amdgcn_exp2f(m - mnew); l *= sc;
#pragma unroll
                for (int r = 0; r < 16; ++r) { o[0][r] *= sc; o[1][r] *= sc; }
                m = mnew; }
            float ls = 0.f;
#pragma unroll
            for (int r = 0; r < 16; ++r) { p0[r] = __builtin_amdgcn_exp2f(p0[r] - m); p1[r] = __builtin_amdgcn_exp2f(p1[r] - m); ls += p0[r] + p1[r]; }
            l += ls;
        }
        pw[0] = pack8(p0, 0); pw[1] = pack8(p0, 8); pw[2] = pack8(p1, 0); pw[3] = pack8(p1, 8);
        if constexpr (SB) { if (more) ATT_LOADV(t - 1); }
#pragma unroll
        for (int d0 = 0; d0 < 2; ++d0)
#pragma unroll
            for (int ks = 0; ks < 4; ++ks) {
                const v4i16_t lo = __builtin_amdgcn_ds_read_tr16_b64_v4i16((LAS v4i16_t*)(vrd + slot * 8192 + d0 * 4096 + ks * 1024));
                const v4i16_t hh = __builtin_amdgcn_ds_read_tr16_b64_v4i16((LAS v4i16_t*)(vrd + slot * 8192 + d0 * 4096 + ks * 1024 + 512));
                const bf16x8 vf = (bf16x8){lo[0], lo[1], lo[2], lo[3], hh[0], hh[1], hh[2], hh[3]};
                o[d0] = __builtin_amdgcn_mfma_f32_32x32x16_bf16(vf, pw[ks], o[d0], 0, 0, 0);
            }
        if (!more) break;
        if constexpr (SB) { if (__all(carry < -ATT_THR)) break; }
        else { const float fe = (t > tw0) ? fwin[kv0 - 1 - wk0] : Frow[kv0 - 1]; const float ub = bqbk + __builtin_fmaf(fe, -LOG2E, FrL); if (__all(ub < m - ATT_THR)) break; }
        ATT_WRITEV(0); --t;
    }
#undef ATT_LOADK
#undef ATT_LOADV
#undef ATT_WRITEV
    float inv = 1.f;
    if constexpr (!SB) { l += __shfl_xor(l, 32); inv = 1.f / l; }
    bf16* op = O + (rowb + q0 + r32) * D + hc + 8 * hi;
#pragma unroll
    for (int d0 = 0; d0 < 2; ++d0)
#pragma unroll
        for (int gp = 0; gp < 2; ++gp) { unsigned wa[2], wb[2];
            wa[0] = cvtpk(o[d0][8 * gp] * inv, o[d0][8 * gp + 1] * inv); wa[1] = cvtpk(o[d0][8 * gp + 2] * inv, o[d0][8 * gp + 3] * inv);
            wb[0] = cvtpk(o[d0][8 * gp + 4] * inv, o[d0][8 * gp + 5] * inv); wb[1] = cvtpk(o[d0][8 * gp + 6] * inv, o[d0][8 * gp + 7] * inv);
            const auto r0 = __builtin_amdgcn_permlane32_swap(wa[0], wb[0], false, false), r1 = __builtin_amdgcn_permlane32_swap(wa[1], wb[1], false, false);
            *(v4u*)(op + 32 * d0 + 16 * gp) = (v4u){r0[0], r1[0], r0[1], r1[1]}; }
}

template <int SL>
__device__ __forceinline__ void attu_fox(int kv0, bool diag, int qabs, int hi, int lane, const bf16x8 (&qr)[4], float FrL, LAS unsigned char* Kring, LAS unsigned char* vrd, const LAS float* fwin,
                                         f32x16 (&o)[2], float& mref, float& mxrun, float& l) {
    bf16x8 kf[8];
#pragma unroll
    for (int p = 0; p < 8; ++p) kf[p] = *(const LAS bf16x8*)(Kring + SL * 8192 + p * 1024 + lane * 16);
    f32x16 p0, p1; const float cm = FrL - mref;
#pragma unroll
    for (int g = 0; g < 4; ++g) { const f32x4 fa = *(const LAS f32x4*)(fwin + kv0 + 8 * g + 4 * hi), fb = *(const LAS f32x4*)(fwin + kv0 + 32 + 8 * g + 4 * hi);
#pragma unroll
        for (int c = 0; c < 4; ++c) { p0[4 * g + c] = fa[c] + cm; p1[4 * g + c] = fb[c] + cm; } }
#pragma unroll
    for (int d0 = 0; d0 < 4; ++d0) { p0 = __builtin_amdgcn_mfma_f32_32x32x16_bf16(kf[2 * d0], qr[d0], p0, 0, 0, 0); p1 = __builtin_amdgcn_mfma_f32_32x32x16_bf16(kf[2 * d0 + 1], qr[d0], p1, 0, 0, 0); }
    if (diag) {
#pragma unroll
        for (int r = 0; r < 16; ++r) { if (kv0 + crow(r, hi) > qabs) p0[r] = -INFINITY; if (kv0 + 32 + crow(r, hi) > qabs) p1[r] = -INFINITY; }
    }
    float ma = fmaxf(fmaxf(p0[0], p0[1]), p0[2]), mb = fmaxf(fmaxf(p1[0], p1[1]), p1[2]);
#pragma unroll
    for (int r = 3; r < 15; r += 2) { ma = fmaxf(fmaxf(ma, p0[r]), p0[r + 1]); mb = fmaxf(fmaxf(mb, p1[r]), p1[r + 1]); }
    float mx = fmaxf(fmaxf(ma, mb), fmaxf(p0[15], p1[15]));
    mx = fmaxf(mx, __shfl_xor(mx, 32));
    mxrun = fmaxf(mxrun, mx);
    if (__any(mx > 0.f)) {
        const float dl = fmaxf(mx, 0.f), sc = __builtin_amdgcn_exp2f(-dl); mref += dl; mxrun -= dl; l *= sc;
#pragma unroll
        for (int r = 0; r < 16; ++r) { p0[r] -= dl; p1[r] -= dl; o[0][r] *= sc; o[1][r] *= sc; }
    }
    float ls0 = 0.f, ls1 = 0.f;
#pragma unroll
    for (int r = 0; r < 16; ++r) { p0[r] = __builtin_amdgcn_exp2f(p0[r]); p1[r] = __builtin_amdgcn_exp2f(p1[r]); ls0 += p0[r]; ls1 += p1[r]; }
    l += ls0 + ls1;
    bf16x8 pw[4];
    pw[0] = pack8(p0, 0); pw[1] = pack8(p0, 8); pw[2] = pack8(p1, 0); pw[3] = pack8(p1, 8);
#pragma unroll
    for (int d0 = 0; d0 < 2; ++d0)
#pragma unroll
        for (int ks = 0; ks < 4; ++ks) {
            const v4i16_t lo = __builtin_amdgcn_ds_read_tr16_b64_v4i16((LAS v4i16_t*)(vrd + SL * 8192 + d0 * 4096 + ks * 1024));
            const v4i16_t hh = __builtin_amdgcn_ds_read_tr16_b64_v4i16((LAS v4i16_t*)(vrd + SL * 8192 + d0 * 4096 + ks * 1024 + 512));
            const bf16x8 vf = (bf16x8){lo[0], lo[1], lo[2], lo[3], hh[0], hh[1], hh[2], hh[3]};
            o[d0] = __builtin_amdgcn_mfma_f32_32x32x16_bf16(vf, pw[ks], o[d0], 0, 0, 0);
        }
}
template <int SL>
__device__ __forceinline__ void attu_sb(int kv0, bool diag, int qabs, int q0, int hi, int lane, const bf16x8 (&qr)[4], const bf16x8 T0, const bf16x8 T1, LAS unsigned char* Kring, LAS unsigned char* vrd,
                                        f32x16 (&o)[2], float& carry) {
    const bool skip1 = diag && !(q0 & 32);
    bf16x8 pw[4]; float rt1 = 0.f, rt0 = 0.f;
    pw[2] = (bf16x8){0, 0, 0, 0, 0, 0, 0, 0}; pw[3] = pw[2];
#define ATTU_SBBLK(BLK, RT, CADD, PWA, PWB) do { f32x16 pb, lbb; \
        _Pragma("unroll") for (int r = 0; r < 16; ++r) pb[r] = 0.f; \
        _Pragma("unroll") for (int d0 = 0; d0 < 4; ++d0) { const bf16x8 kq = *(const LAS bf16x8*)(Kring + SL * 8192 + (2 * d0 + BLK) * 1024 + lane * 16); pb = __builtin_amdgcn_mfma_f32_32x32x16_bf16(kq, qr[d0], pb, 0, 0, 0); } \
        if (diag) { _Pragma("unroll") for (int r = 0; r < 16; ++r) { const float z = pb[r], lg = __builtin_amdgcn_logf(1.f + __builtin_amdgcn_exp2f(-fabsf(z))); const float lbv = fminf(z, 0.f) - lg; float lm = lbv - z; \
                const bool valid = (kv0 + 32 * BLK + crow(r, hi) < qabs); lm = valid ? lm : 0.f; lbb[r] = valid ? lbv : -INFINITY; pb[r] = lm; RT += lm; } } \
        else { _Pragma("unroll") for (int r = 0; r < 16; ++r) { const float z = pb[r], lg = __builtin_amdgcn_logf(1.f + __builtin_amdgcn_exp2f(-fabsf(z))); const float lbv = fminf(z, 0.f) - lg; const float lm = lbv - z; lbb[r] = lbv; pb[r] = lm; RT += lm; } } \
        RT += __shfl_xor(RT, 32); \
        { const bf16x8 ma = pack8(pb, 0), mb = pack8(pb, 8); const float ca_ = (CADD); \
          _Pragma("unroll") for (int r = 0; r < 16; ++r) lbb[r] += ca_; \
          lbb = __builtin_amdgcn_mfma_f32_32x32x16_bf16(T0, ma, lbb, 0, 0, 0); lbb = __builtin_amdgcn_mfma_f32_32x32x16_bf16(T1, mb, lbb, 0, 0, 0); } \
        _Pragma("unroll") for (int r = 0; r < 16; ++r) pb[r] = __builtin_amdgcn_exp2f(lbb[r]); \
        PWA = pack8(pb, 0); PWB = pack8(pb, 8); } while (0)
    if (!skip1) ATTU_SBBLK(1, rt1, carry, pw[2], pw[3]);
    ATTU_SBBLK(0, rt0, carry + rt1, pw[0], pw[1]);
#undef ATTU_SBBLK
    carry += rt0 + rt1;
#pragma unroll
    for (int d0 = 0; d0 < 2; ++d0)
#pragma unroll
        for (int ks = 0; ks < 4; ++ks) { if (ks >= 2 && skip1) continue;
            const v4i16_t lo = __builtin_amdgcn_ds_read_tr16_b64_v4i16((LAS v4i16_t*)(vrd + SL * 8192 + d0 * 4096 + ks * 1024));
            const v4i16_t hh = __builtin_amdgcn_ds_read_tr16_b64_v4i16((LAS v4i16_t*)(vrd + SL * 8192 + d0 * 4096 + ks * 1024 + 512));
            const bf16x8 vf = (bf16x8){lo[0], lo[1], lo[2], lo[3], hh[0], hh[1], hh[2], hh[3]};
            o[d0] = __builtin_amdgcn_mfma_f32_32x32x16_bf16(vf, pw[ks], o[d0], 0, 0, 0);
        }
}
template <bool SB>
__device__ __forceinline__ void attn_unit(int b, int hc, int q0u, const bf16* Q, const bf16* K, const bf16* V, bf16* O, const float* Frow, float bk2, LAS unsigned char* lds, LAS unsigned char* flagb, int wave, int lane_, bool domath = true) {
    int lane = lane_; asm volatile("" : "+v"(lane));
    const int r32 = lane & 31, hi = lane >> 5, half = wave >> 2, hw = wave & 3;
    const size_t rowb = (size_t)b * SEQ;
    const bf16* Kh = K + rowb * D + hc; const bf16* Vh = V + rowb * D + hc;
    const int q0h = q0u + 128 * half, q0 = q0h + hw * 32, qabs = q0 + r32;
    const int ttop = (q0h >> 6) + 1, tdw = q0 >> 6;
    LAS unsigned char* Kring = lds + half * 49152; LAS unsigned char* Vring = Kring + 24576;
    LAS float* fwin = (LAS float*)(lds + 98304);
    const unsigned kdst0 = (unsigned)(size_t)(Kring + hw * 1024), vdst0 = (unsigned)(size_t)(Vring + hw * 1024);
    const bf16* ksrc0 = Kh + (size_t)(32 * (hw & 1) + r32) * D + 16 * (hw >> 1) + 8 * hi;
    const bf16* vsrc0 = Vh + (size_t)(16 * hw + (lane >> 2)) * D + 8 * (lane & 3);
#define ATTU_DMA(t_, slot_) do { const int tt_ = (t_) < 0 ? 0 : (t_); \
        glds16(ksrc0 + (size_t)tt_ * 64 * D, (unsigned)__builtin_amdgcn_readfirstlane((int)(kdst0 + (slot_) * 8192))); \
        glds16(ksrc0 + (size_t)tt_ * 64 * D + 32, (unsigned)__builtin_amdgcn_readfirstlane((int)(kdst0 + (slot_) * 8192 + 4096))); \
        glds16(vsrc0 + (size_t)tt_ * 64 * D, (unsigned)__builtin_amdgcn_readfirstlane((int)(vdst0 + (slot_) * 8192))); \
        glds16(vsrc0 + (size_t)tt_ * 64 * D + 32, (unsigned)__builtin_amdgcn_readfirstlane((int)(vdst0 + (slot_) * 8192 + 4096))); } while (0)
    ATTU_DMA(ttop, 0); ATTU_DMA(ttop - 1, 1);
    bf16x8 qr[4];
#pragma unroll
    for (int j = 0; j < 4; ++j) qr[j] = *(const bf16x8*)(Q + (rowb + q0 + (r32 & ~3) + j) * D + hc + 16 * (r32 & 3) + 8 * hi);
    if constexpr (!SB) {
        const int tid_ = wave * 64 + lane;
#pragma unroll
        for (int i = 0; i < 2; ++i) { const int idx = 4 * tid_ + 2048 * i; if (idx < q0u + 256) *(LAS f32x4*)(fwin + idx) = *(const f32x4*)(Frow + idx) * (-LOG2E); }
    }
    if (lane == 0) { flagb[wave] = 0; flagb[8 + wave] = 0; }
    asm volatile("" : "+v"(qr[0]), "+v"(qr[1]), "+v"(qr[2]), "+v"(qr[3]));
    { const bool od_ = (lane & 1) != 0, h2_ = (lane & 2) != 0;
      v4u qv[4] = {__builtin_bit_cast(v4u, qr[0]), __builtin_bit_cast(v4u, qr[1]), __builtin_bit_cast(v4u, qr[2]), __builtin_bit_cast(v4u, qr[3])};
#pragma unroll
      for (int d = 0; d < 4; ++d) { unsigned w_[4] = {qv[0][d], qv[1][d], qv[2][d], qv[3][d]};
#pragma unroll
          for (int p_ = 0; p_ < 4; p_ += 2) { const unsigned s_ = od_ ? w_[p_] : w_[p_ + 1]; const unsigned r_ = (unsigned)__builtin_amdgcn_update_dpp(0, (int)s_, 0xB1, 0xf, 0xf, true); w_[p_] = od_ ? r_ : w_[p_]; w_[p_ + 1] = od_ ? w_[p_ + 1] : r_; }
#pragma unroll
          for (int p_ = 0; p_ < 2; ++p_) { const unsigned s_ = h2_ ? w_[p_] : w_[p_ + 2]; const unsigned r_ = (unsigned)__builtin_amdgcn_update_dpp(0, (int)s_, 0x4E, 0xf, 0xf, true); w_[p_] = h2_ ? r_ : w_[p_]; w_[p_ + 2] = h2_ ? w_[p_ + 2] : r_; }
          qv[0][d] = w_[0]; qv[1][d] = w_[1]; qv[2][d] = w_[2]; qv[3][d] = w_[3]; }
#pragma unroll
      for (int c = 0; c < 4; ++c) qr[c] = __builtin_bit_cast(bf16x8, qv[c]); }
    LAS unsigned char* vrd = Vring + ((lane >> 4) & 1) * 32 + (lane & 3) * 8 + (4 * hi + ((lane & 15) >> 2)) * 64;
    f32x16 o[2];
#pragma unroll
    for (int r = 0; r < 16; ++r) { o[0][r] = 0.f; o[1][r] = 0.f; }
    float mref = 0.f, mxrun = -INFINITY, l = 0.f, FrL = 0.f, bqbk = 0.f, carry = 0.f; bf16x8 T0, T1;
    if constexpr (SB) {
        v4u a, c;
#pragma unroll
        for (int w = 0; w < 4; ++w) { unsigned lo, hi2;
            { const int jj = 2 * w; const int j0 = 8 * (jj >> 2) + 4 * hi + (jj & 3), j1 = j0 + 1;
              lo = ((j0 > r32) ? 0x3F80u : 0u) | ((j1 > r32) ? 0x3F800000u : 0u); hi2 = ((16 + j0 > r32) ? 0x3F80u : 0u) | ((16 + j1 > r32) ? 0x3F800000u : 0u); }
            a[w] = lo; c[w] = hi2; }
        T0 = __builtin_bit_cast(bf16x8, a); T1 = __builtin_bit_cast(bf16x8, c);
    } else {
        T0 = (bf16x8){0, 0, 0, 0, 0, 0, 0, 0}; T1 = T0;
        FrL = Frow[q0] * LOG2E;
        float qs = 0.f;
#pragma unroll
        for (int d0 = 0; d0 < 4; ++d0) { const v4u w = __builtin_bit_cast(v4u, qr[d0]);
#pragma unroll
            for (int e = 0; e < 4; ++e) { const float x0 = bflo(w[e]), x1 = bfhi(w[e]); qs += x0 * x0 + x1 * x1; } }
        qs += __shfl_xor(qs, 32);
#pragma unroll
        for (int off = 1; off < 32; off <<= 1) qs = fmaxf(qs, __shfl_xor(qs, off));
        bqbk = sqrtf(qs * bk2) * 1.02f + 0.01f;
        asm volatile("" : "+v"(FrL), "+v"(bqbk));
    }
    bool fin = false;
    int s = 0;
#define ATTU_STEP(SL) { const int t = ttop - s, kv0 = t * 64; \
          \
        asm volatile("s_waitcnt vmcnt(4) lgkmcnt(0)\n\ts_barrier" ::: "memory"); \
        if (s > 0) { const v2u f2 = *(const LAS v2u*)(flagb + ((s - 1) & 1) * 8); if (__builtin_amdgcn_readfirstlane((int)((f2.x & f2.y) == 0x01010101u))) break; } \
        ATTU_DMA(t - 2, (SL + 2) % 3);     \
        if (!domath) { if (t <= 0) fin = true; }          \
        else if (t <= tdw && t >= 0 && !fin) { \
            if constexpr (SB) { attu_sb<SL>(kv0, t == tdw, qabs, q0, hi, lane, qr, T0, T1, Kring, vrd, o, carry); \
                fin = (t == 0) || __all(carry < -ATT_THR); } \
            else { attu_fox<SL>(kv0, t == tdw, qabs, hi, lane, qr, FrL, Kring, vrd, fwin, o, mref, mxrun, l); \
                fin = (t == 0) || __all(bqbk + fwin[t > 0 ? kv0 - 1 : 0] + FrL < mref + mxrun - ATT_THR); } } \
        if (lane == 0) flagb[(s & 1) * 8 + wave] = fin ? 1 : 0; \
        ++s; }
    for (;;) { ATTU_STEP(0) ATTU_STEP(1) ATTU_STEP(2) }
#undef ATTU_STEP
    asm volatile("s_waitcnt vmcnt(0) lgkmcnt(0)\n\ts_barrier" ::: "memory");
#undef ATTU_DMA
    if (!domath) return;
    float inv = 1.f;
    if constexpr (!SB) { l += __shfl_xor(l, 32); inv = 1.f / l; }
    v4u val[4];
#pragma unroll
    for (int d0 = 0; d0 < 2; ++d0)
#pragma unroll
        for (int gp = 0; gp < 2; ++gp) { unsigned wa[2], wb[2];
            wa[0] = cvtpk(o[d0][8 * gp] * inv, o[d0][8 * gp + 1] * inv); wa[1] = cvtpk(o[d0][8 * gp + 2] * inv, o[d0][8 * gp + 3] * inv);
            wb[0] = cvtpk(o[d0][8 * gp + 4] * inv, o[d0][8 * gp + 5] * inv); wb[1] = cvtpk(o[d0][8 * gp + 6] * inv, o[d0][8 * gp + 7] * inv);
            const auto r0 = __builtin_amdgcn_permlane32_swap(wa[0], wb[0], false, false), r1 = __builtin_amdgcn_permlane32_swap(wa[1], wb[1], false, false);
            val[2 * d0 + gp] = (v4u){r0[0], r1[0], r0[1], r1[1]}; }
    { const bool od_ = (lane & 1) != 0, h2_ = (lane & 2) != 0;
#pragma unroll
      for (int d = 0; d < 4; ++d) { unsigned w_[4] = {val[0][d], val[1][d], val[2][d], val[3][d]};
#pragma unroll
          for (int p_ = 0; p_ < 4; p_ += 2) { const unsigned s_ = od_ ? w_[p_] : w_[p_ + 1]; const unsigned r_ = (unsigned)__builtin_amdgcn_update_dpp(0, (int)s_, 0xB1, 0xf, 0xf, true); w_[p_] = od_ ? r_ : w_[p_]; w_[p_ + 1] = od_ ? w_[p_ + 1] : r_; }
#pragma unroll
          for (int p_ = 0; p_ < 2; ++p_) { const unsigned s_ = h2_ ? w_[p_] : w_[p_ + 2]; const unsigned r_ = (unsigned)__builtin_amdgcn_update_dpp(0, (int)s_, 0x4E, 0xf, 0xf, true); w_[p_] = h2_ ? r_ : w_[p_]; w_[p_ + 2] = h2_ ? w_[p_ + 2] : r_; }
          val[0][d] = w_[0]; val[1][d] = w_[1]; val[2][d] = w_[2]; val[3][d] = w_[3]; } }
    { bf16* op = O + (rowb + q0 + (r32 & ~3)) * D + hc + 16 * (r32 & 3) + 8 * hi;
#pragma unroll
      for (int j = 0; j < 4; ++j) *(v4u*)(op + (size_t)j * D) = val[j]; }
}
}

struct Frame {
    LAS unsigned char* lds;
    int tid, lane, wave, vcu, G;
};
__device__ __forceinline__ int opaque_tid(int wave_s) { int l; asm volatile("v_mbcnt_lo_u32_b32 %0, -1, 0\n\tv_mbcnt_hi_u32_b32 %0, -1, %0" : "=v"(l)); return wave_s * 64 + l; }
#define PHASE_IDS const int tid = opaque_tid(wave_s); const int lane = tid & 63; const int wave = __builtin_amdgcn_readfirstlane(tid >> 6); F.tid = tid; F.lane = lane; F.wave = wave
__device__ __forceinline__ float wave_sum(float v) {
#pragma unroll
    for (int o = 1; o < 64; o <<= 1) v += __shfl_xor(v, o);
    return v;
}
__device__ __forceinline__ float sigmoid_f(float v) { return 1.f / (1.f + __expf(-v)); }
__device__ __forceinline__ float log_sigmoid_f(float v) { return fminf(v, 0.f) - log1pf(expf(-fabsf(v))); }

struct TrItem { const float* src; bf16* dst; int ldw, ldt; float fp8scale; };
struct TrOut { __amdgpu_buffer_rsrc_t r; const unsigned char* base; };
__device__ __forceinline__ void tr_load(const TrItem& t, f32x4 (&r)[8], int lane) {
#pragma unroll
    for (int i = 0; i < 8; ++i) r[i] = *(const GAS f32x4*)(t.src + (size_t)((lane >> 3) + 8 * i) * t.ldw + 4 * (lane & 7));
}
__device__ __forceinline__ void tr_finish(const TrItem& t, const f32x4 (&r)[8], LAS float* scr, int lane, const TrOut& wo) {
#pragma unroll
    for (int i = 0; i < 8; ++i) { LAS float* p = scr + ((lane >> 3) + 8 * i) * 33 + 4 * (lane & 7); p[0] = r[i].x; p[1] = r[i].y; p[2] = r[i].z; p[3] = r[i].w; }
    LDS_WAIT(); asm volatile("" ::: "memory");
    if (t.fp8scale != 0.f) {
        const float sc = t.fp8scale; const int c = lane & 3;
#pragma unroll
        for (int j = 0; j < 2; ++j) { const int n = (lane >> 2) + 16 * j; const LAS float* s = scr + (16 * c) * 33 + n; v4u o;
#pragma unroll
            for (int q = 0; q < 4; ++q) { unsigned w0 = __builtin_amdgcn_cvt_pk_fp8_f32(s[(4 * q) * 33] * sc, s[(4 * q + 1) * 33] * sc, 0, false); o[q] = __builtin_amdgcn_cvt_pk_fp8_f32(s[(4 * q + 2) * 33] * sc, s[(4 * q + 3) * 33] * sc, w0, true); }
            __builtin_amdgcn_raw_buffer_store_b128(o, wo.r, (unsigned)(((const unsigned char*)t.dst + (size_t)n * t.ldt + 16 * c) - wo.base), 0, 16); }
    } else {
        const int c = lane & 7;
#pragma unroll
    for (int j = 0; j < 4; ++j) { const int n = (lane >> 3) + 8 * j; const LAS float* s = scr + (8 * c) * 33 + n;
        v4u o; o.x = pk2(s[0 * 33], s[1 * 33]); o.y = pk2(s[2 * 33], s[3 * 33]); o.z = pk2(s[4 * 33], s[5 * 33]); o.w = pk2(s[6 * 33], s[7 * 33]);
        __builtin_amdgcn_raw_buffer_store_b128(o, wo.r, (unsigned)((const unsigned char*)(t.dst + (size_t)n * t.ldt + 8 * c) - wo.base), 0, 16); }
    }
    LDS_WAIT(); asm volatile("" ::: "memory");
}
__device__ __forceinline__ int win_src_col(int n0) {
    if (n0 < 512) return n0;
    if (n0 < 1024) return 1544 + (n0 - 512);
    if (n0 < 1536) return 512 + (n0 - 1024);
    if (n0 < 2048) return 2056 + (n0 - 1536);
    if (n0 < 2560) return 1024 + (n0 - 2048);
    if (n0 < 3072) return 2568 + (n0 - 2560);
    if (n0 < 4096) return 3080 + (n0 - 3072);
    return 4104 + (n0 - 4096);
}

struct Args { const float* in[19]; float* out; unsigned char* ws; int ph_lo, ph_hi; };


#define P1N_LOAD(buf, p) do { const GAS f32x4* xa_ = (const GAS f32x4*)(x + (size_t)(rb * 128 + wave + 16 * (p)) * D) + lane; \
        _Pragma("unroll") for (int j = 0; j < 4; ++j) { buf[0][j] = xa_[64 * j]; buf[1][j] = xa_[64 * j + 8 * (D / 4)]; } } while (0)
#define P1N_PAIR(buf, p) do { const int m0 = rb * 128 + wave + 16 * (p); \
        float ss0 = 0.f, ss1 = 0.f; \
        _Pragma("unroll") for (int j = 0; j < 4; ++j) { ss0 += (buf[0][j].x * buf[0][j].x + buf[0][j].y * buf[0][j].y) + (buf[0][j].z * buf[0][j].z + buf[0][j].w * buf[0][j].w); \
                                                        ss1 += (buf[1][j].x * buf[1][j].x + buf[1][j].y * buf[1][j].y) + (buf[1][j].z * buf[1][j].z + buf[1][j].w * buf[1][j].w); } \
        const float rstd0 = __builtin_amdgcn_rsqf(wave_sum(ss0) * (1.f / D) + RMS_EPS), rstd1 = __builtin_amdgcn_rsqf(wave_sum(ss1) * (1.f / D) + RMS_EPS); \
        f32x4 fa[2][2]; fa[0][0] = fa[0][1] = fa[1][0] = fa[1][1] = (f32x4){0.f, 0.f, 0.f, 0.f}; \
        GAS v2u* o8 = (GAS v2u*)(XN + (size_t)m0 * D) + lane; GAS unsigned* o4 = (GAS unsigned*)(XN8 + (size_t)m0 * D) + lane; \
        _Pragma("unroll") for (int j = 0; j < 4; ++j) { asm volatile("" ::: "memory"); const f32x4 g = *(const LAS f32x4*)(gsl + 4 * lane + 256 * j), sh = *(const LAS f32x4*)(shl + 4 * lane + 256 * j); \
            const f32x4 h0 = buf[0][j] * rstd0 * g + sh, h1 = buf[1][j] * rstd1 * g + sh; \
            o8[64 * j] = (v2u){att::cvtpk(h0.x, h0.y), att::cvtpk(h0.z, h0.w)}; o8[64 * j + 8 * (D / 4)] = (v2u){att::cvtpk(h1.x, h1.y), att::cvtpk(h1.z, h1.w)}; \
            { unsigned w8 = __builtin_amdgcn_cvt_pk_fp8_f32(h0.x, h0.y, 0, false); w8 = __builtin_amdgcn_cvt_pk_fp8_f32(h0.z, h0.w, w8, true); o4[64 * j] = w8; } \
            { unsigned w8 = __builtin_amdgcn_cvt_pk_fp8_f32(h1.x, h1.y, 0, false); w8 = __builtin_amdgcn_cvt_pk_fp8_f32(h1.z, h1.w, w8, true); o4[64 * j + 8 * (D / 4)] = w8; } \
            _Pragma("unroll") for (int c = 0; c < 4; ++c) { const f32x4 wa_ = wl[((j * 4 + c) * 2) * 64 + lane], wb_ = wl[((j * 4 + c) * 2 + 1) * 64 + lane]; \
                fa[0][0] += h0[c] * wa_; fa[0][1] += h0[c] * wb_; fa[1][0] += h1[c] * wa_; fa[1][1] += h1[c] * wb_; } } \
        _Pragma("unroll") for (int rr = 0; rr < 2; ++rr) { float g4[4], g2[2], g1;   \
            { const bool up = (lane & 32) != 0; const float f[8] = {fa[rr][0].x, fa[rr][0].y, fa[rr][0].z, fa[rr][0].w, fa[rr][1].x, fa[rr][1].y, fa[rr][1].z, fa[rr][1].w}; \
              _Pragma("unroll") for (int c = 0; c < 4; ++c) { const float snd = up ? f[c] : f[c + 4], kp = up ? f[c + 4] : f[c]; g4[c] = kp + __shfl_xor(snd, 32); } } \
            { const bool up = (lane & 16) != 0; \
              _Pragma("unroll") for (int c = 0; c < 2; ++c) { const float snd = up ? g4[c] : g4[c + 2], kp = up ? g4[c + 2] : g4[c]; g2[c] = kp + __shfl_xor(snd, 16); } } \
            { const bool up = (lane & 8) != 0; const float snd = up ? g2[0] : g2[1], kp = up ? g2[1] : g2[0]; g1 = kp + __shfl_xor(snd, 8); } \
            g1 += __shfl_xor(g1, 4); g1 += __shfl_xor(g1, 2); g1 += __shfl_xor(g1, 1); \
            if ((lane & 7) == 0) { const float val = g1 + bfg; LOGF[(size_t)(b * 8 + (lane >> 3)) * SEQ + ((m0 + 8 * rr) % SEQ)] = fminf(val, 0.f) - __logf(1.f + __expf(-fabsf(val))); } } } while (0)
__device__ __forceinline__ void p1_norm(const Args& args, Frame& F, const float* x, bf16* XN, unsigned char* XN8, float* LOGF, const float* mod) {
    const int wave = F.wave;
    LAS float* gsl = (LAS float*)(F.lds + TAB_OFF);
    LAS float* shl = (LAS float*)(F.lds + TAB_OFF + 4096);
    LAS f32x4* wl = (LAS f32x4*)F.lds;
    for (int rb = F.vcu; rb < NTOK / 128; rb += F.G) {
        const int b = rb / 32;
        int lane = F.lane; asm volatile("" : "+v"(lane));
        __syncthreads();
        for (int k = wave * 64 + lane; k < D; k += NWAVES * 64) { gsl[k] = args.in[4][k] * (1.f + mod[b * NMOD * D + D + k]); shl[k] = mod[b * NMOD * D + k]; }
#pragma unroll
        for (int q4 = 0; q4 < 4; ++q4) { const int q = wave * 4 + q4, jc = q >> 1, k = 4 * lane + 256 * (jc >> 2) + (jc & 3);
            wl[q * 64 + lane] = *(const f32x4*)(args.in[5] + (size_t)k * NIN + 1536 + 4 * (q & 1)); }
        __syncthreads();
        const float bfg = args.in[6][(lane >> 3) & 7];
        f32x4 A[2][4], B[2][4];
        P1N_LOAD(A, 0);
        _Pragma("nounroll") for (int p = 0; p < 8; p += 2) {
            P1N_LOAD(B, p + 1);
            P1N_PAIR(A, p);
            if (p + 2 < 8) P1N_LOAD(A, p + 2);
            P1N_PAIR(B, p + 1);
        }
    }
}
#undef P1N_LOAD
#undef P1N_PAIR
__device__ __forceinline__ TrItem tr_decode(const Args& args, int it, bf16* WIN, unsigned char* WIN8, bf16* WBR, bf16* WOUT, bf16* WGU, bf16* WD) {
    constexpr int I_WIN = 16 * 160, I_BR = 8 * 32, I_OUT = 16 * 32, I_G = 16 * 256;
    int r = it; TrItem t; t.fp8scale = 0.f;
    if (r < I_WIN) { const int kb = r / 160, nb = r % 160; t.src = args.in[5] + (size_t)(64 * kb) * NIN + win_src_col(32 * nb); t.ldw = NIN;
        if (nb < 64) { t.dst = WIN + (size_t)(32 * nb) * D + 64 * kb; t.ldt = D; }
        else if (nb < 96) { t.dst = (bf16*)(WIN8 + (size_t)(2048 + 32 * (nb - 64)) * D + 64 * kb); t.ldt = D; t.fp8scale = 32.f; }
        else { t.dst = (bf16*)(WIN8 + (size_t)(32 * (nb - 96)) * D + 64 * kb); t.ldt = D; t.fp8scale = 32.f; }
        return t; } r -= I_WIN;
    if (r < I_BR) { const int kb = r / 32, nb = r % 32; t.src = args.in[7] + (size_t)(64 * kb) * D + 32 * nb; t.ldw = D; t.dst = WBR + (size_t)(32 * nb) * D + 64 * kb; t.ldt = D; return t; } r -= I_BR;
    if (r < I_BR) { const int kb = r / 32, nb = r % 32; t.src = args.in[8] + (size_t)(64 * kb) * D + 32 * nb; t.ldw = D; t.dst = WBR + (size_t)(32 * nb) * D + 512 + 64 * kb; t.ldt = D; return t; } r -= I_BR;
    if (r < I_OUT) { const int kb = r / 32, nb = r % 32; t.src = args.in[9] + (size_t)(64 * kb) * D + 32 * nb; t.ldw = D; t.dst = WOUT + (size_t)(32 * nb) * D + 64 * kb; t.ldt = D; return t; } r -= I_OUT;
    if (r < 2 * I_G) { const int up = r / I_G; r -= up * I_G; const int e = r / 256, q = r % 256, kb = q / 16, nb = q % 16, n0 = 32 * nb;
        t.src = args.in[15 + up] + (size_t)e * D * DFF + (size_t)(64 * kb) * DFF + n0; t.ldw = DFF;
        t.dst = (bf16*)((unsigned char*)WGU + (size_t)e * D * D + (size_t)(256 * (n0 / 128) + (n0 % 128) + 128 * up) * D + 64 * kb); t.ldt = D; t.fp8scale = 32.f; return t; } r -= 2 * I_G;
    { const int e = r / 256, q = r % 256, kb = q / 32, nb = q % 32; t.src = args.in[17] + (size_t)e * DFF * D + (size_t)(64 * kb) * D + 32 * nb; t.ldw = D;
      t.dst = (bf16*)((unsigned char*)WD + (size_t)e * D * DFF + (size_t)(32 * nb) * DFF + 64 * kb); t.ldt = DFF; t.fp8scale = 16.f; return t; }
}
constexpr int TR_NITEMS = 16 * 160 + 2 * 8 * 32 + 16 * 32 + 2 * 16 * 256 + 16 * 256, TR_EXP0 = 16 * 160 + 2 * 8 * 32 + 16 * 32 + 2 * 16 * 256;
__device__ __forceinline__ void p1_trans(const Args& args, Frame& F, bf16* WIN, unsigned char* WIN8, bf16* WBR, bf16* WOUT, bf16* WGU, bf16* WD, const TrOut& wo, int first, int NITEMS, int gw_, int NGW) {
    const int lane = F.lane, wave = F.wave; const int gw = first + gw_;
    LAS float* scr = (LAS float*)(F.lds + wave * 16384);
    if (gw >= NITEMS) return;
    f32x4 ra[8], rb[8];
    TrItem cur = tr_decode(args, gw, WIN, WIN8, WBR, WOUT, WGU, WD);
    tr_load(cur, ra, lane);
    for (int it = gw; it < NITEMS; it += NGW) {
        const int nx = it + NGW; TrItem nt = cur;
        if (nx < NITEMS) { nt = tr_decode(args, nx, WIN, WIN8, WBR, WOUT, WGU, WD); tr_load(nt, rb, lane); }
        tr_finish(cur, ra, scr, lane, wo);
#pragma unroll
        for (int i = 0; i < 8; ++i) ra[i] = rb[i];
        cur = nt;
    }
}

__global__ void __launch_bounds__(NWAVES * 64, 2) fwd(Args args) {
    extern __shared__ __attribute__((aligned(16))) unsigned char lds_raw[];
    Frame F;
    F.lds = (LAS unsigned char*)lds_raw;
    const int wave_s = __builtin_amdgcn_readfirstlane((int)threadIdx.x >> 6);
    F.tid = threadIdx.x; F.lane = F.tid & 63; F.wave = wave_s;
    F.G = gridDim.x; { const int bx = blockIdx.x; F.vcu = (F.G % 8 == 0) ? (bx % 8) * (F.G / 8) + bx / 8 : bx; }
    unsigned char* ws = args.ws;
    unsigned* ctl = (unsigned*)(ws + WS_CTL);
    volatile LAS unsigned* MISC = (volatile LAS unsigned*)(F.lds + MISC_OFF);
    for (int u = F.tid; u < 256; u += NWAVES * 64) ((LAS unsigned*)(F.lds + MISC_OFF))[u] = 0u;
    __syncthreads();
    XcdBarrier bar = xcd_barrier_post(ctl + CW_BAR, MISC + 8, F.tid);
    unsigned long long pc0_; asm volatile("s_getpc_b64 %0" : "=s"(pc0_));
    const unsigned char* cwarm_init = (const unsigned char*)((pc0_ + 127ull) & ~127ull) + (size_t)(F.vcu & 31) * 4864; const unsigned char* cwarm = cwarm_init;
    LAS unsigned char* cjunk = F.lds + MISC_OFF + 512;
    const __amdgpu_buffer_rsrc_t wsr = __builtin_amdgcn_make_buffer_rsrc((void*)ws, (short)0, (int)WS_END, 0x00020000);
    const int lo = args.ph_lo, hi = args.ph_hi;
#define IN(k) (lo <= (k) && (k) < hi)
#define BOTH(k) (IN(k) && IN((k) + 1))
    float* mod = (float*)(ws + WS_MOD);
    float* LOGF = (float*)(ws + WS_LOGF);
    float* FC = (float*)(ws + WS_F);
    bf16* WIN = (bf16*)(ws + WS_WIN); bf16* WBR = (bf16*)(ws + WS_WBR); bf16* WOUT = (bf16*)(ws + WS_WOUT); bf16* WGU = (bf16*)(ws + WS_WGU); bf16* WD = (bf16*)(ws + WS_WD);
    bf16* XN = (bf16*)(ws + WS_XN); bf16* QB = (bf16*)(ws + WS_Q); bf16* KB = (bf16*)(ws + WS_K); bf16* VB = (bf16*)(ws + WS_V); bf16* GAB = (bf16*)(ws + WS_GA); bf16* GBB = (bf16*)(ws + WS_GB);
    bf16* ACT = (bf16*)(ws + WS_ACT); bf16* YB = (bf16*)(ws + WS_Y); bf16* X1B = (bf16*)(ws + WS_V);
    int* LIST = (int*)(ws + WS_LIST); float* LW = (float*)(ws + WS_LW);
    const float* x = args.in[0];

    if (IN(0)) _Pragma("nounroll") for (int rep_ = 0; rep_ < NREP0; ++rep_) {
        PHASE_IDS;
        LAS float* cs = (LAS float*)F.lds;
        LAS float* red = (LAS float*)(F.lds + 32768);
        for (int i = tid; i < BATCH * D; i += NWAVES * 64) { const float v = args.in[1][i]; cs[i] = v / (1.f + expf(-v)); }
        __syncthreads();
        if (F.vcu < 192) {
            const int cc = tid & 31, ks = tid >> 5, col = F.vcu * 32 + cc;
            float a[8];
#pragma unroll
            for (int b = 0; b < 8; ++b) a[b] = 0.f;
            const float* wp = args.in[2] + col;
            for (int k0 = ks * 64; k0 < ks * 64 + 64; k0 += 16) { float w[16];
#pragma unroll
                for (int i = 0; i < 16; ++i) w[i] = wp[(size_t)(k0 + i) * (NMOD * D)];
#pragma unroll
                for (int i = 0; i < 16; ++i)
#pragma unroll
                    for (int b = 0; b < 8; ++b) a[b] += cs[b * D + k0 + i] * w[i]; }
#pragma unroll
            for (int b = 0; b < 8; ++b) red[(ks * 8 + b) * 32 + cc] = a[b];
            __syncthreads();
            if (tid < 256) { const int b = tid >> 5; float s = 0.f;
#pragma unroll
                for (int q = 0; q < 16; ++q) s += red[(q * 8 + b) * 32 + cc];
                mod[b * (NMOD * D) + F.vcu * 32 + cc] = s + args.in[3][F.vcu * 32 + cc]; }
        }
        asm volatile("s_waitcnt vmcnt(0)" ::: "memory");
        __syncthreads();
        if (tid == 0 && F.vcu < 192) { __builtin_amdgcn_fence(__ATOMIC_RELEASE, "agent"); asm volatile("s_waitcnt vmcnt(0)" ::: "memory"); (void)xb_add(ctl + CW_MODCNT, 1u); }
    }

    if (IN(1)) _Pragma("nounroll") for (int rep_ = 0; rep_ < NREP1; ++rep_) {
        PHASE_IDS;
        p1_trans(args, F, WIN, (unsigned char*)(ws + WS_WIN8), WBR, WOUT, WGU, WD, TrOut{wsr, ws}, 0, TR_EXP0, F.vcu * NWAVES + wave, F.G * NWAVES);
        asm volatile("s_waitcnt vmcnt(0)" ::: "memory");
        __syncthreads();
        if (tid == 0) { (void)xb_add(ctl + CW_WREADY, 1u); xcd_census(bar); unsigned sp = 0; while (xb_ld(ctl + CW_MODCNT) < 192u) { __builtin_amdgcn_s_sleep(2); if (++sp > (1u << 22)) break; }
            __builtin_amdgcn_fence(__ATOMIC_ACQUIRE, "agent"); asm volatile("s_waitcnt vmcnt(0)" ::: "memory"); }
        __syncthreads();
        { const bool xl_ = (MISC[10] != 0u) && (F.G == 256); if (xl_) F.vcu = (int)bar.x * 32 + (int)MISC[11]; }
        p1_norm(args, F, x, XN, (unsigned char*)(ws + WS_XN8), LOGF, mod);
        asm volatile("s_waitcnt vmcnt(0)" ::: "memory");
        if ((MISC[10] != 0u) && (F.G == 256) && lane == 0) (void)xb_add(ctl + CW_NORM + 64 * (int)bar.x, 1u);
        __syncthreads();
        if (wave == 7 && lane < 38) __builtin_amdgcn_global_load_lds((const unsigned*)(cwarm + lane * 128), (LAS unsigned*)cjunk, 4, 0, 0);
        p1_trans(args, F, WIN, (unsigned char*)(ws + WS_WIN8), WBR, WOUT, WGU, WD, TrOut{wsr, ws}, TR_EXP0, TR_NITEMS, (int)blockIdx.x * NWAVES + wave, F.G * NWAVES);
        if (BOTH(1) && !((MISC[10] != 0u) && (F.G == 256))) xcd_barrier(bar, opaque_tid(wave_s), cwarm, cjunk);
    }
    const bool xlocal = (MISC[10] != 0u) && (F.G == 256) && IN(1);
    const int xq = xlocal ? (int)bar.x : ((int)blockIdx.x & 7), xr = xlocal ? (int)MISC[11] : ((int)blockIdx.x >> 3);
    const int cdeal = (F.G % 8 == 0) ? xr * 8 + xq : (int)blockIdx.x;
    if (F.G % 8 == 0) F.vcu = xq * (F.G / 8) + xr;
    cwarm = (const unsigned char*)((pc0_ + 127ull) & ~127ull) + (size_t)(xr & 31) * 4864;
    if (xlocal) {
        if (opaque_tid(wave_s) == 0) { unsigned sp = 0; while (xb_ld(ctl + CW_WREADY) < (unsigned)F.G || xb_ld(ctl + CW_NORM + 64 * xq) < 256u) { __builtin_amdgcn_s_sleep(2); if (++sp > (1u << 22)) break; }
            __builtin_amdgcn_fence(__ATOMIC_ACQUIRE, "agent"); asm volatile("s_waitcnt vmcnt(0)" ::: "memory"); }
        __syncthreads();
    }
#define GRID_OR_LOCAL_BARRIER() do { if (xlocal) xcd_barrier_local(bar, opaque_tid(wave_s), cwarm, cjunk); else xcd_barrier(bar, opaque_tid(wave_s), cwarm, cjunk); } while (0)

    if (IN(2)) _Pragma("nounroll") for (int rep_ = 0; rep_ < NREP2; ++rep_) {
        PHASE_IDS;
        for (int bh = xlocal ? ((xr < 8) ? xq * 8 + xr : 64) : F.vcu; bh < 64; bh += xlocal ? 64 : F.G) {
            LAS float* wt = (LAS float*)F.lds;
            const float* src = LOGF + (size_t)bh * SEQ + tid * 8; float* dst = FC + (size_t)bh * SEQ + tid * 8;
            const f32x4 a = *(const f32x4*)src, c = *(const f32x4*)(src + 4);
            float p[8]; p[0] = a.x; p[1] = p[0] + a.y; p[2] = p[1] + a.z; p[3] = p[2] + a.w; p[4] = p[3] + c.x; p[5] = p[4] + c.y; p[6] = p[5] + c.z; p[7] = p[6] + c.w;
            float incl = p[7];
#pragma unroll
            for (int o = 1; o < 64; o <<= 1) { const float t = __shfl_up(incl, o); if (lane >= o) incl += t; }
            if (lane == 63) wt[wave] = incl;
            __syncthreads();
            float base = incl - p[7];
            for (int w = 0; w < wave; ++w) base += wt[w];
            *(f32x4*)dst = (f32x4){p[0] + base, p[1] + base, p[2] + base, p[3] + base}; *(f32x4*)(dst + 4) = (f32x4){p[4] + base, p[5] + base, p[6] + base, p[7] + base};
            __syncthreads();
        }
        { pg8::Gemm g{(const bf16*)(ws + WS_XN8), (const bf16*)(ws + WS_WIN8 + (size_t)2048 * D), D / 2, D / 2, D / 2, 127, 127}; pg8::StaticOrder S; S.init(NTOK, D, F.G, cdeal, GREP2);
          pg8::EpiSplit E{VB, D, D, 0, 1.f, nullptr, 0.03125f, false};
          pg8::gemm_phase<pg8::EpiSplit, pg8::StaticOrder, true, false, true>(F.lds, g, S, E, nullptr, tid); }
        { pg8::Gemm g{XN, WIN, D, D, D, 127, 127}; pg8::StaticOrder S; S.init(NTOK, 2 * D, F.G, cdeal, GREP2);
          pg8::EpiSplit E{QB, D, D, (size_t)(WS_K - WS_Q) / 2, C2, ctl + CW_KMAX, 1.f, false};
          pg8::gemm_phase<pg8::EpiSplit, pg8::StaticOrder, true, false>(F.lds, g, S, E, nullptr, opaque_tid(wave_s)); }
        if (rep_ == 0 && opaque_tid(wave_s) == 0) (void)xb_add(ctl + CW_WEREADY, 1u);
        if (BOTH(2)) GRID_OR_LOCAL_BARRIER();
    }

    if (IN(3)) _Pragma("nounroll") for (int rep_ = 0; rep_ < NREP3; ++rep_) {
        PHASE_IDS;
        for (int uid = F.vcu, it_ = 0; uid < 2048; uid += F.G, ++it_) {
            int type = uid >> 10, idx = uid & 1023, bh = idx >> 4, b = bh >> 3, h = bh & 7, q0u = (idx & 15) * 256;
            if (xlocal) { const int combo = xr + 32 * (it_ & 3); type = it_ >> 2; b = xq; h = combo >> 4; bh = b * 8 + h; q0u = (combo & 15) * 256; }
            if (type == 0) {
                const float k2 = __builtin_bit_cast(float, __hip_atomic_load(ctl + CW_KMAX + bh * 2, __ATOMIC_RELAXED, __HIP_MEMORY_SCOPE_AGENT)) + __builtin_bit_cast(float, __hip_atomic_load(ctl + CW_KMAX + bh * 2 + 1, __ATOMIC_RELAXED, __HIP_MEMORY_SCOPE_AGENT));
                att::attn_unit<false>(b, h * 64, q0u, QB, KB, VB, XN, FC + (size_t)bh * SEQ, k2, F.lds, (LAS unsigned char*)(F.lds + MISC_OFF + 128), wave, lane, !(PROBE_ATT == 3 && rep_ != NREP3 - 1));
            } else {
                att::attn_unit<true>(b, 512 + h * 64, q0u, QB, KB, VB, XN, nullptr, 0.f, F.lds, (LAS unsigned char*)(F.lds + MISC_OFF + 128), wave, opaque_tid(wave_s) & 63, !(PROBE_ATT == 3 && rep_ != NREP3 - 1));
            }
            if (xlocal && it_ > 0 && (opaque_tid(wave_s) & 63) == 0) (void)xb_add(ctl + CW_ATT + 64 * xq, 1u);
        }
        if (xlocal) { asm volatile("s_waitcnt vmcnt(0)" ::: "memory"); if ((opaque_tid(wave_s) & 63) == 0) (void)xb_add(ctl + CW_ATT + 64 * xq, 1u); }
        if (BOTH(3) && !xlocal) xcd_barrier(bar, opaque_tid(wave_s), cwarm, cjunk);
    }

    if (IN(4)) _Pragma("nounroll") for (int rep_ = 0; rep_ < NREP4; ++rep_) {
        PHASE_IDS;
        { pg8::Gemm g{(const bf16*)(ws + WS_XN8), (const bf16*)(ws + WS_WIN8), D / 2, D / 2, D / 2, 127, 127}; pg8::GateOrder S; S.M.init(NTOK, D, F.G, cdeal, GREP4);
          pg8::EpiGate8 E{(unsigned char*)GAB, 0.03125f};
          pg8::gemm_phase<pg8::EpiGate8, pg8::GateOrder, true, false, true>(F.lds, g, S, E, nullptr, tid); }
        if (xlocal) {
            if (opaque_tid(wave_s) == 0) { unsigned sp = 0; while (xb_ld(ctl + CW_ATT + 64 * xq) < 2048u) { __builtin_amdgcn_s_sleep(2); if (++sp > (1u << 22)) break; }
                __builtin_amdgcn_fence(__ATOMIC_ACQUIRE, "agent"); asm volatile("s_waitcnt vmcnt(0)" ::: "memory"); }
            __syncthreads(); }
        { pg8::Gemm g{XN, WBR, D, D, D, 127, 127}; pg8::StaticOrder S; S.init(NTOK, D, F.G, cdeal, GREP4);
          pg8::EpiMerge E{(const unsigned char*)GAB, KB};
          pg8::gemm_phase<pg8::EpiMerge, pg8::StaticOrder, true, false>(F.lds, g, S, E, nullptr, opaque_tid(wave_s)); }
        if (BOTH(4)) GRID_OR_LOCAL_BARRIER();
    }

    if (IN(5)) _Pragma("nounroll") for (int rep_ = 0; rep_ < NREP5; ++rep_) {
        PHASE_IDS;
        pg8::Gemm g{KB, WOUT, D, D, D, 127, 127}; pg8::StaticOrder S; S.init(NTOK, D, F.G, cdeal, GREP5);
        pg8::EpiResid E{x, mod + 2 * D, X1B, (float*)(ws + WS_SSQ)};
        pg8::gemm_phase<pg8::EpiResid, pg8::StaticOrder, true, false>(F.lds, g, S, E, nullptr, tid);
        if (BOTH(5)) GRID_OR_LOCAL_BARRIER();
    }

    if (IN(6)) _Pragma("nounroll") for (int rep_ = 0; rep_ < NREP6; ++rep_) {
        PHASE_IDS;
        LAS v4u* BH0 = (LAS v4u*)F.lds;
        LAS v4u* BL0 = (LAS v4u*)(F.lds + 32768);
        LAS v4u* BH1 = (LAS v4u*)(F.lds + 65536);
        LAS v4u* BL1 = (LAS v4u*)(F.lds + 73728);
        LAS float* gsl = (LAS float*)(F.lds + 81920);
        LAS float* shl = (LAS float*)(F.lds + 86016);
        LAS float* lsc = (LAS float*)(F.lds + 90112) + wave * 320;
        LAS int* selE = (LAS int*)(F.lds + 100352);
        LAS float* selW = (LAS float*)(F.lds + 100864);
        LAS int* lcnt = (LAS int*)(F.lds + 101888);
        LAS int* lpos = (LAS int*)(F.lds + 102016);
        const float* SSQ = (const float*)(ws + WS_SSQ);
#pragma unroll
        for (int it_ = 0; it_ < 5; ++it_) { const int en = tid + it_ * (NWAVES * 64);
            float w[8];
            if (en < 2048) { const int s_ = en >> 6, ln = en & 63, c = ln & 15, kg = ln >> 4;
#pragma unroll
                for (int j = 0; j < 8; ++j) w[j] = args.in[13][(size_t)(128 * (s_ >> 2) + 32 * kg + 8 * (s_ & 3) + j) * 16 + c]; }
            else { const int e2 = en - 2048, s_ = e2 >> 4, kg = (e2 >> 2) & 3, c = e2 & 3;
#pragma unroll
                for (int j = 0; j < 8; ++j) w[j] = args.in[11][(size_t)(128 * (s_ >> 2) + 32 * kg + 8 * (s_ & 3) + j) * 4 + c]; }
            v4u hi4, lo4;
#pragma unroll
            for (int j = 0; j < 4; ++j) { const unsigned hp = att::cvtpk(w[2 * j], w[2 * j + 1]); hi4[j] = hp; lo4[j] = att::cvtpk(w[2 * j] - bflo(hp), w[2 * j + 1] - bfhi(hp)); }
            if (en < 2048) { BH0[en] = hi4; BL0[en] = lo4; } else { BH1[en - 2048] = hi4; BL1[en - 2048] = lo4; }
        }
        for (int rb = F.vcu; rb < NTOK / 128; rb += F.G) {
        const int b = rb / 32;
        __syncthreads();
        if (tid < 32) lcnt[tid] = 0;
        for (int k = tid; k < D; k += NWAVES * 64) { gsl[k] = args.in[10][k] * (1.f + mod[b * NMOD * D + 4 * D + k]); shl[k] = mod[b * NMOD * D + 3 * D + k]; }
        __syncthreads();
        {
            int ln6 = lane; asm volatile("" : "+v"(ln6));
            const int rw = ln6 & 15, kg = ln6 >> 4, m = rb * 128 + wave * 16 + rw;
            v4u xall[8][4];
            { const bf16* xr_ = X1B + (size_t)m * D + 32 * kg;
#pragma unroll
              for (int S = 0; S < 8; ++S)
#pragma unroll
                  for (int q = 0; q < 4; ++q) xall[S][q] = *(const v4u*)(xr_ + 128 * S + 8 * q); }
            float ssq = 0.f;
#pragma unroll
            for (int i = 0; i < 4; ++i) { const f32x4 t4 = *(const f32x4*)(SSQ + (size_t)m * 16 + 4 * i); ssq += (t4.x + t4.y) + (t4.z + t4.w); }
            const float rstd = __builtin_amdgcn_rsqf(ssq * (1.f / D) + RMS_EPS);
            const bf16* xrow = X1B + (size_t)m * D + 32 * kg; unsigned char* hrow = (unsigned char*)XN + (size_t)m * D + 32 * kg;
            f32x4 acc0 = (f32x4){0.f, 0.f, 0.f, 0.f}, acc1 = acc0;
#pragma unroll
            for (int S = 0; S < 8; ++S) {
                asm volatile("" ::: "memory");
                unsigned h8[8];
#pragma unroll
                for (int q = 0; q < 4; ++q) { const int s_ = 4 * S + q, k0 = 128 * S + 32 * kg + 8 * q; const v4u xq = xall[S][q];
                    const f32x4 ga = *(const LAS f32x4*)(gsl + k0), gb = *(const LAS f32x4*)(gsl + k0 + 4);
                    const f32x4 sa = *(const LAS f32x4*)(shl + k0), sb = *(const LAS f32x4*)(shl + k0 + 4);
                    const f32x4 xa_ = (f32x4){bflo(xq.x), bfhi(xq.x), bflo(xq.y), bfhi(xq.y)}, xb_ = (f32x4){bflo(xq.z), bfhi(xq.z), bflo(xq.w), bfhi(xq.w)};
                    const f32x4 ha = xa_ * rstd * ga + sa, hb = xb_ * rstd * gb + sb;
                    v4u hi4, lo4;
                    hi4.x = att::cvtpk(ha.x, ha.y); hi4.y = att::cvtpk(ha.z, ha.w); hi4.z = att::cvtpk(hb.x, hb.y); hi4.w = att::cvtpk(hb.z, hb.w);
                    lo4.x = att::cvtpk(ha.x - bflo(hi4.x), ha.y - bfhi(hi4.x)); lo4.y = att::cvtpk(ha.z - bflo(hi4.y), ha.w - bfhi(hi4.y));
                    lo4.z = att::cvtpk(hb.x - bflo(hi4.z), hb.y - bfhi(hi4.z)); lo4.w = att::cvtpk(hb.z - bflo(hi4.w), hb.w - bfhi(hi4.w));
                    { unsigned w0 = __builtin_amdgcn_cvt_pk_fp8_f32(ha.x, ha.y, 0, false); w0 = __builtin_amdgcn_cvt_pk_fp8_f32(ha.z, ha.w, w0, true);
                      unsigned w1 = __builtin_amdgcn_cvt_pk_fp8_f32(hb.x, hb.y, 0, false); w1 = __builtin_amdgcn_cvt_pk_fp8_f32(hb.z, hb.w, w1, true);
                      h8[2 * q] = w0; h8[2 * q + 1] = w1; }
                    const bf16x8 ah = __builtin_bit_cast(bf16x8, hi4), al = __builtin_bit_cast(bf16x8, lo4);
                    const bf16x8 bh0 = __builtin_bit_cast(bf16x8, BH0[s_ * 64 + ln6]), bl0 = __builtin_bit_cast(bf16x8, BL0[s_ * 64 + ln6]);
                    const bf16x8 bh1 = __builtin_bit_cast(bf16x8, BH1[s_ * 16 + kg * 4 + (rw & 3)]), bl1 = __builtin_bit_cast(bf16x8, BL1[s_ * 16 + kg * 4 + (rw & 3)]);
                    acc0 = __builtin_amdgcn_mfma_f32_16x16x32_bf16(ah, bh0, acc0, 0, 0, 0); acc0 = __builtin_amdgcn_mfma_f32_16x16x32_bf16(al, bh0, acc0, 0, 0, 0); acc0 = __builtin_amdgcn_mfma_f32_16x16x32_bf16(ah, bl0, acc0, 0, 0, 0);
                    acc1 = __builtin_amdgcn_mfma_f32_16x16x32_bf16(ah, bh1, acc1, 0, 0, 0); acc1 = __builtin_amdgcn_mfma_f32_16x16x32_bf16(al, bh1, acc1, 0, 0, 0); acc1 = __builtin_amdgcn_mfma_f32_16x16x32_bf16(ah, bl1, acc1, 0, 0, 0);
                }
                *(v4u*)(hrow + 128 * S) = (v4u){h8[0], h8[1], h8[2], h8[3]}; *(v4u*)(hrow + 128 * S + 16) = (v4u){h8[4], h8[5], h8[6], h8[7]};
            }
#pragma unroll
            for (int i = 0; i < 4; ++i) { lsc[(4 * kg + i) * 20 + 4 + rw] = acc0[i]; if (rw < 4) lsc[(4 * kg + i) * 20 + rw] = acc1[i]; }
            LDS_WAIT(); asm volatile("" ::: "memory");
            if (lane < 16) {
                float lg[20];
#pragma unroll
                for (int i = 0; i < 20; ++i) lg[i] = lsc[lane * 20 + i];
#pragma unroll
                for (int i = 0; i < 4; ++i) lg[i] += args.in[12][i];
#pragma unroll
                for (int i = 0; i < 16; ++i) lg[4 + i] += args.in[14][i];
                int gi = 0; float gm = lg[0];
#pragma unroll
                for (int i = 1; i < 4; ++i) if (lg[i] > gm) { gm = lg[i]; gi = i; }
                float gsum = 0.f;
#pragma unroll
                for (int i = 0; i < 4; ++i) gsum += expf(lg[i] - gm);
                const float gp = 1.f / gsum;
                float es[4];
#pragma unroll
                for (int i = 0; i < 4; ++i) es[i] = (gi == 0) ? lg[4 + i] : (gi == 1) ? lg[8 + i] : (gi == 2) ? lg[12 + i] : lg[16 + i];
                int i1 = 0; float m1 = es[0];
#pragma unroll
                for (int i = 1; i < 4; ++i) if (es[i] > m1) { m1 = es[i]; i1 = i; }
                int i2 = -1; float m2 = -3.0e38f;
#pragma unroll
                for (int i = 0; i < 4; ++i) if (i != i1 && es[i] > m2) { m2 = es[i]; i2 = i; }
                const float p2 = expf(m2 - m1), inv = 1.f / (1.f + p2);
                const int rl = wave * 16 + lane;
                selE[rl] = (gi * 4 + i1) | ((gi * 4 + i2) << 8); selW[2 * rl] = gp * inv; selW[2 * rl + 1] = gp * p2 * inv;
            }
        }
        __syncthreads();
        int my_e = 0;
        if (rep_ == NREP6 - 1) {
        if (tid < 256) { const int se = selE[tid >> 1]; my_e = (tid & 1) ? (se >> 8) & 255 : se & 255; lpos[tid] = __hip_atomic_fetch_add(&lcnt[my_e], 1, __ATOMIC_RELAXED, __HIP_MEMORY_SCOPE_WORKGROUP); }
        __syncthreads();
        if (tid < 16) lcnt[16 + tid] = (int)__hip_atomic_fetch_add(ctl + CW_CNT + 64 * tid, (unsigned)lcnt[tid], __ATOMIC_RELAXED, __HIP_MEMORY_SCOPE_AGENT);
        __syncthreads();
        if (tid < 256) { const int pos = lcnt[16 + my_e] + lpos[tid]; LIST[my_e * NTOK + pos] = (rb * 128 + (tid >> 1)) * 2 + (tid & 1); LW[my_e * NTOK + pos] = selW[tid]; }
        }
        }
        if (BOTH(6)) xcd_barrier(bar, opaque_tid(wave_s), cwarm, cjunk);
    }

    LAS int* tab = (LAS int*)(F.lds + TAB_OFF);
    LAS int* gtab = (LAS int*)(F.lds + TAB_OFF + 512);
    if (IN(7) || IN(8)) {
        PHASE_IDS;
        if (tid == 32) { unsigned sp = 0; while (xb_ld(ctl + CW_WEREADY) < (unsigned)F.G) { __builtin_amdgcn_s_sleep(2); if (++sp > (1u << 22)) break; } }
        if (tid < 16) tab[32 + tid] = (int)__hip_atomic_load(ctl + CW_CNT + 64 * tid, __ATOMIC_RELAXED, __HIP_MEMORY_SCOPE_AGENT);
        __syncthreads();
        if (tid == 0) { int acc_t = 0;
            for (int e = 0; e < 16; ++e) { const int c = tab[32 + e]; tab[e] = acc_t; acc_t += (c + 255) >> 8; }
            tab[16] = acc_t;
            const int nun = acc_t * 4; int cnt_u = 0; LAS int* ul = tab + 64;
            for (int i = 0; i < 14; ++i) { int L = i * F.G + F.vcu; if (L >= nun * GREP7) break; L %= nun; const int rt = L >> 2; int e = 0;
                for (int k = 1; k < 16; ++k) e += (rt >= tab[k]) ? 1 : 0;
                ul[4 + 4 * i] = rt; ul[5 + 4 * i] = L & 3; ul[6 + 4 * i] = e; ul[7 + 4 * i] = (rt - tab[e]) * 256; cnt_u = i + 1; }
            ul[0] = cnt_u;
            LAS int* ul8 = gtab + 14 * 256;
            if (!xlocal) { for (int i = 0; i < 4 + 4 * 14; ++i) ul8[i] = ul[i]; }
            else { const int p0x = (xq * acc_t) >> 3, nxp = (((xq + 1) * acc_t) >> 3) - p0x, n7 = 4 * nxp; int c7 = 0, c8 = 0;
                const int rem7 = n7 & 31, cat = rem7 ? 32 - rem7 : 0, full = (n7 - cat) >> 5, part = (n7 - cat) & 31;
                for (int k = 0; k < 14; ++k) { int ph, loc;
                    if (k < 7) { ph = 0; loc = xr + 32 * k; if (loc >= n7) continue; }
                    else { ph = 1; const int kk = k - 7;
                        if (kk == 0) { if (!(cat && xr >= rem7)) continue; loc = xr - rem7; }
                        else if (kk <= full) loc = cat + 32 * (kk - 1) + xr;
                        else if (kk == full + 1) { const int pos = 31 - xr; if (pos >= part) continue; loc = cat + 32 * full + pos; }
                        else continue; }
                    const int rt = p0x + (loc >> 2); int e = 0;
                    for (int q = 1; q < 16; ++q) e += (rt >= tab[q]) ? 1 : 0;
                    LAS int* dstl = ph ? ul8 : ul; const int i = ph ? c8++ : c7++;
                    dstl[4 + 4 * i] = rt; dstl[5 + 4 * i] = loc & 3; dstl[6 + 4 * i] = e; dstl[7 + 4 * i] = (rt - tab[e]) * 256; }
                ul[0] = c7; ul8[0] = c8; } }
        __syncthreads();
    }
    if (IN(7)) _Pragma("nounroll") for (int rep_ = 0; rep_ < NREP7; ++rep_) {
        PHASE_IDS;
        pg8::MoeOrder S{tab + 64, (size_t)D * D, true, xlocal ? ctl + CW_TILE : nullptr, nullptr};
        { const LAS int* ul = tab + 64; const int nun = ul[0];
          int tk[7];
#pragma unroll
          for (int j = 0; j < 7; ++j) { const int i = (tid >> 8) + 2 * j; tk[j] = 0;
              if (i < nun) { const int e = ul[6 + 4 * i], pos = ul[7 + 4 * i] + (tid & 255); if (pos < tab[32 + e]) tk[j] = LIST[e * NTOK + pos] >> 1; } }
#pragma unroll
          for (int j = 0; j < 7; ++j) { const int i = (tid >> 8) + 2 * j; if (i < nun) gtab[i * 256 + (tid & 255)] = tk[j]; } }
        __syncthreads();
        pg8::Gemm g{XN, WGU, D / 2, D / 2, D / 2, 127, 127};
        pg8::EpiAct E{(unsigned char*)ACT};
        pg8::gemm_phase<pg8::EpiAct, pg8::MoeOrder, true, true, true>(F.lds, g, S, E, gtab, tid);
        if (BOTH(7)) { if (!xlocal) xcd_barrier(bar, opaque_tid(wave_s), cwarm, cjunk);
            else { if (opaque_tid(wave_s) == 0) { __builtin_amdgcn_fence(__ATOMIC_ACQUIRE, "agent"); asm volatile("s_waitcnt vmcnt(0)" ::: "memory"); }
                   __syncthreads(); } }
    }
    if (IN(8)) _Pragma("nounroll") for (int rep_ = 0; rep_ < NREP8; ++rep_) {
        PHASE_IDS;
        LAS unsigned* okm = (LAS unsigned*)(F.lds + MISC_OFF) + 13;
        if (xlocal) { if (tid < 16) { const LAS int* ul8 = gtab + 14 * 256; const int n8 = ul8[0]; unsigned okb = 0u;
                if (tid < n8) okb = (__hip_atomic_load(ctl + CW_TILE + ul8[4 + 4 * tid], __ATOMIC_RELAXED, __HIP_MEMORY_SCOPE_AGENT) >= 32u) ? (1u << tid) : 0u;
                okb |= __shfl_xor(okb, 1); okb |= __shfl_xor(okb, 2); okb |= __shfl_xor(okb, 4); okb |= __shfl_xor(okb, 8);
                if (tid == 0) *okm = okb; }
            __syncthreads(); }
        pg8::MoeOrder S{gtab + 14 * 256, (size_t)D * DFF, false, nullptr, xlocal ? ctl + CW_TILE : nullptr, okm};
        pg8::Gemm g{ACT, WD, DFF / 2, DFF / 2, DFF / 2, 127, 127};
        pg8::EpiDown E{LIST, LW, tab, YB};
        pg8::gemm_phase<pg8::EpiDown, pg8::MoeOrder, true, false, true>(F.lds, g, S, E, nullptr, tid);
        if (BOTH(8)) xcd_barrier(bar, opaque_tid(wave_s), cwarm, cjunk);
    }
    if (IN(9)) _Pragma("nounroll") for (int rep_ = 0; rep_ < NREP9; ++rep_) {
        PHASE_IDS;
        for (int rb = F.vcu; rb < NTOK / 128; rb += F.G) {
        const int b = rb / 32;
        f32x4 g2[4], fg[4];
#pragma unroll
        for (int j = 0; j < 4; ++j) { const int k = 4 * lane + 256 * j; g2[j] = *(const f32x4*)(mod + b * NMOD * D + 5 * D + k); fg[j] = *(const f32x4*)(args.in[18] + k); }
        {
        v2u xv[4], nx[4]; unsigned ya[4], yb[4], na[4], nb[4];
        const unsigned char* Y8 = (const unsigned char*)YB;
        { const int m = rb * 128 + wave; const GAS v2u* xr = (const GAS v2u*)(X1B + (size_t)m * D) + lane;
          const GAS unsigned* y0 = (const GAS unsigned*)(Y8 + (size_t)m * D) + lane; const GAS unsigned* y1 = (const GAS unsigned*)(Y8 + (size_t)(NTOK + m) * D) + lane;
#pragma unroll
          for (int j = 0; j < 4; ++j) { xv[j] = xr[64 * j]; ya[j] = y0[64 * j]; yb[j] = y1[64 * j]; } }
        for (int r = wave; r < 128; r += NWAVES) {
            const int m = rb * 128 + r;
            if (r + NWAVES < 128) { const int m2 = m + NWAVES; const GAS v2u* xr = (const GAS v2u*)(X1B + (size_t)m2 * D) + lane;
                const GAS unsigned* y0 = (const GAS unsigned*)(Y8 + (size_t)m2 * D) + lane; const GAS unsigned* y1 = (const GAS unsigned*)(Y8 + (size_t)(NTOK + m2) * D) + lane;
#pragma unroll
                for (int j = 0; j < 4; ++j) { nx[j] = xr[64 * j]; na[j] = y0[64 * j]; nb[j] = y1[64 * j]; } }
            f32x4 v[4]; float ss = 0.f;
#pragma unroll
            for (int j = 0; j < 4; ++j) { typedef float f2_ __attribute__((ext_vector_type(2)));
                const f2_ a0 = __builtin_amdgcn_cvt_pk_f32_fp8((int)ya[j], false), a1 = __builtin_amdgcn_cvt_pk_f32_fp8((int)ya[j], true), c0 = __builtin_amdgcn_cvt_pk_f32_fp8((int)yb[j], false), c1 = __builtin_amdgcn_cvt_pk_f32_fp8((int)yb[j], true);
                const f32x4 ys = (f32x4){a0.x + c0.x, a0.y + c0.y, a1.x + c1.x, a1.y + c1.y} * 0.0625f;
                v[j] = (f32x4){bflo(xv[j].x), bfhi(xv[j].x), bflo(xv[j].y), bfhi(xv[j].y)} + g2[j] * ys; ss += (v[j].x * v[j].x + v[j].y * v[j].y) + (v[j].z * v[j].z + v[j].w * v[j].w); }
            const float rstd = 1.f / sqrtf(wave_sum(ss) * (1.f / D) + RMS_EPS);
            { GAS f32x4* dr = (GAS f32x4*)(args.out + (size_t)m * D) + lane;
#pragma unroll
              for (int j = 0; j < 4; ++j) dr[64 * j] = v[j] * rstd * fg[j]; }
#pragma unroll
            for (int j = 0; j < 4; ++j) { xv[j] = nx[j]; ya[j] = na[j]; yb[j] = nb[j]; }
        }
        }
        }
    }
#undef IN
#undef BOTH
}

extern "C" void kernel_launch(void* const* d_in, const int* in_sizes, int n_in, void* d_out, int out_size, void* d_ws, size_t ws_size, hipStream_t stream) {
    static int grid = 0;
    if (grid == 0) {
        if (n_in != 19 || in_sizes[0] != NTOK * D || out_size != NTOK * D || ws_size < WS_END) { fprintf(stderr, "kernel_launch: unexpected problem shape (n_in %d, ws %zu)\n", n_in, ws_size); grid = -1; return; }
        int dev = 0, cus = 0, per_cu = 0;
        if (hipGetDevice(&dev) != hipSuccess || hipDeviceGetAttribute(&cus, hipDeviceAttributeMultiprocessorCount, dev) != hipSuccess) { grid = -1; return; }
        if (hipFuncSetAttribute((const void*)fwd, hipFuncAttributeMaxDynamicSharedMemorySize, LDS_BYTES) != hipSuccess) { grid = -1; return; }
        if (hipOccupancyMaxActiveBlocksPerMultiprocessor(&per_cu, (const void*)fwd, NWAVES * 64, LDS_BYTES) != hipSuccess || per_cu < 1) { fprintf(stderr, "kernel_launch: occupancy query reports %d\n", per_cu); }
        (void)hipGetLastError();
        grid = cus;
    }
    if (grid < 0) return;
    if (hipMemsetAsync((char*)d_ws + WS_CTL, 0, CTL_ZERO_BYTES, stream) != hipSuccess) return;
    Args a{};
    for (int i = 0; i < 19; ++i) a.in[i] = (const float*)d_in[i];
    a.out = (float*)d_out; a.ws = (unsigned char*)d_ws; a.ph_lo = 0; a.ph_hi = 10;
    hipLaunchKernelGGL(fwd, dim3(grid), dim3(NWAVES * 64), LDS_BYTES, stream, a);
}
```
